# Optimizing an MI355X kernel written in HIP

```python
import jax, jax.numpy as jnp
from jax import lax
import numpy as np

D_MODEL = 1024
BATCH = 16
SEQ = 2048
DEPTH = 2

N_EVEN = (DEPTH + 1) // 2
N_ODD = DEPTH // 2
MIX_HALF = D_MODEL // 2

HGRN_HEADS = 4
HGRN_DK = 128
HGRN_DV = MIX_HALF // HGRN_HEADS
HGRN_CHUNK = 64
HGRN_K = HGRN_HEADS * HGRN_DK
HGRN_V = HGRN_HEADS * HGRN_DV
SGU_GROUPS = 4
SGU_CH = MIX_HALF // SGU_GROUPS
SGU_CHUNK = 128
CONV_CH = MIX_HALF
CONV_WIDTH = 31
MLA_HEADS = 4
MLA_NOPE = 128
MLA_ROPE = 64
MLA_V = 128
MLA_Q_RANK = 384
MLA_KV_RANK = 256
ATTN_BLOCK = 128
ROPE_THETA = 10000.0
D_FF = -(-8 * D_MODEL // (3 * 256)) * 256
EPS = 1e-6

IN_EVEN = 2 * HGRN_K + 2 * HGRN_V + 2 * MIX_HALF
IN_ODD = 2 * CONV_CH + MLA_Q_RANK + MLA_KV_RANK + MLA_ROPE

kernel_name = "hgrn2_gmlp_conformer_mla_hybrid"

F32 = jnp.float32


def rmsnorm(x, w):
    xf = x.astype(F32)
    y = xf * lax.rsqrt(jnp.mean(xf * xf, axis=-1, keepdims=True) + EPS)
    return (y * w.astype(F32)).astype(x.dtype)


def layernorm(x, g, b):
    xf = x.astype(F32)
    mu = jnp.mean(xf, axis=-1, keepdims=True)
    var = jnp.mean(jnp.square(xf - mu), axis=-1, keepdims=True)
    y = (xf - mu) * lax.rsqrt(var + EPS)
    return (y * g.astype(F32) + b.astype(F32)).astype(x.dtype)


def hgrn2(q, f_pre, i, g, lb, gnorm_w):
    B, T, _ = q.shape
    nc = T // HGRN_CHUNK
    lb = lb.astype(F32)
    f = lb + (1.0 - lb) * jax.nn.sigmoid(f_pre.astype(F32))
    log_f = jnp.log(f)
    k = 1.0 - f

    def to_chunks(a, d):
        return a.astype(F32).reshape(B, nc, HGRN_CHUNK, HGRN_HEADS, d).transpose(1, 0, 3, 2, 4)

    qc, kc, lfc = to_chunks(q, HGRN_DK), to_chunks(k, HGRN_DK), to_chunks(log_f, HGRN_DK)
    ic = to_chunks(i, HGRN_DV)
    causal = jnp.tril(jnp.ones((HGRN_CHUNK, HGRN_CHUNK), bool))[:, :, None]

    def step(S, inp):
        qb, kb, lfb, ib = inp
        b = jnp.cumsum(lfb, axis=2)
        o_inter = jnp.einsum('bhtd,bhdv->bhtv', qb * jnp.exp(b), S)
        diff = b[:, :, :, None, :] - b[:, :, None, :, :]
        decay = jnp.exp(jnp.where(causal, diff, -jnp.inf))
        scores = jnp.einsum('bhtd,bhtsd,bhsd->bhts', qb, decay, kb)
        o_intra = jnp.einsum('bhts,bhsv->bhtv', scores, ib)
        b_last = b[:, :, -1:, :]
        S = (jnp.exp(b_last[:, :, 0, :, None]) * S
             + jnp.einsum('bhsd,bhsv->bhdv', kb * jnp.exp(b_last - b), ib))
        return S, o_inter + o_intra

    S0 = jnp.zeros((B, HGRN_HEADS, HGRN_DK, HGRN_DV), F32)
    _, o = lax.scan(step, S0, (qc, kc, lfc, ic))
    o = o.transpose(1, 0, 3, 2, 4).reshape(B, T, HGRN_HEADS, HGRN_DV)
    o = rmsnorm(o, gnorm_w.reshape(HGRN_HEADS, HGRN_DV)).reshape(B, T, HGRN_V)
    return (o * jax.nn.silu(g.astype(F32))).astype(g.dtype)


def spatial_gating(u, v, ln_g, ln_b, w_s, b_s):
    B, T, _ = u.shape
    nc = T // SGU_CHUNK
    vn = layernorm(v.reshape(B, T, SGU_GROUPS, SGU_CH),
                   ln_g.reshape(SGU_GROUPS, SGU_CH), ln_b.reshape(SGU_GROUPS, SGU_CH))
    vn = vn.reshape(B, nc, SGU_CHUNK, SGU_GROUPS, SGU_CH)
    w = w_s * jnp.tril(jnp.ones((SGU_CHUNK, SGU_CHUNK), w_s.dtype))[None]
    z = jnp.einsum('gts,bnsgc->bntgc', w, vn) + b_s.T[:, :, None]
    return u * z.reshape(B, T, SGU_GROUPS * SGU_CH)


def conformer_conv(h_glu, conv_w, conv_b, ln_g, ln_b):
    a, gate = jnp.split(h_glu, 2, axis=-1)
    h = a * jax.nn.sigmoid(gate)
    h = lax.conv_general_dilated(h, conv_w[:, None, :].astype(h.dtype), window_strides=(1,),
                                 padding=[(CONV_WIDTH - 1, 0)],
                                 dimension_numbers=('NWC', 'WIO', 'NWC'),
                                 feature_group_count=CONV_CH) + conv_b
    return jax.nn.silu(layernorm(h, ln_g, ln_b))


def rope_tables(positions):
    inv = 1.0 / (ROPE_THETA ** (jnp.arange(0, MLA_ROPE, 2, dtype=F32) / MLA_ROPE))
    ang = positions.astype(F32)[..., None] * inv
    return jnp.cos(ang), jnp.sin(ang)


def apply_rope(x, cos, sin):
    x1, x2 = jnp.split(x.astype(F32), 2, axis=-1)
    return jnp.concatenate([x1 * cos - x2 * sin, x1 * sin + x2 * cos], axis=-1).astype(x.dtype)


def causal_mla_attention(q_nope, q_rope, k_nope, k_rope, v):
    T = q_nope.shape[1]
    scale = (MLA_NOPE + MLA_ROPE) ** -0.5
    outs = []
    for start in range(0, T, ATTN_BLOCK):
        end = start + ATTN_BLOCK
        s = (jnp.einsum('bqhd,bkhd->bhqk', q_nope[:, start:end], k_nope[:, :end],
                        preferred_element_type=F32)
             + jnp.einsum('bqhr,bkr->bhqk', q_rope[:, start:end], k_rope[:, :end],
                          preferred_element_type=F32)) * scale
        mask = (start + jnp.arange(ATTN_BLOCK))[:, None] >= jnp.arange(end)[None, :]
        p = jax.nn.softmax(jnp.where(mask, s, -jnp.inf), axis=-1)
        outs.append(jnp.einsum('bhqk,bkhv->bqhv', p.astype(v.dtype), v[:, :end]))
    return jnp.concatenate(outs, axis=1)


def mla(c_q, c_kv, k_rope_pre, positions, q_norm, w_uq, kv_norm, w_ukv):
    B, T, _ = c_q.shape
    q = (rmsnorm(c_q, q_norm) @ w_uq).reshape(B, T, MLA_HEADS, MLA_NOPE + MLA_ROPE)
    q_nope, q_rope = q[..., :MLA_NOPE], q[..., MLA_NOPE:]
    kv = (rmsnorm(c_kv, kv_norm) @ w_ukv).reshape(B, T, MLA_HEADS, MLA_NOPE + MLA_V)
    k_nope, v = kv[..., :MLA_NOPE], kv[..., MLA_NOPE:]
    cos, sin = rope_tables(positions)
    q_rope = apply_rope(q_rope, cos[:, :, None, :], sin[:, :, None, :])
    k_rope = apply_rope(k_rope_pre, cos, sin)
    o = causal_mla_attention(q_nope, q_rope, k_nope, k_rope, v)
    return o.reshape(B, T, MLA_HEADS * MLA_V)


def swiglu(h, w_gate, w_up, w_down):
    return (jax.nn.silu(h @ w_gate) * (h @ w_up)) @ w_down


def setup_inputs(seed: int = 0) -> dict:
    key = jax.random.key(seed)
    ks = iter(jax.random.split(key, 32))

    def dense(shape, fan_in):
        return jax.random.normal(next(ks), shape, F32) * fan_in ** -0.5

    def gain(shape):
        return 1.0 + 0.02 * jax.random.normal(next(ks), shape, F32)

    def bias(shape):
        return 0.02 * jax.random.normal(next(ks), shape, F32)

    x = jax.random.normal(next(ks), (BATCH, SEQ, D_MODEL), F32)
    offsets = jax.random.randint(next(ks), (BATCH, 1), 0, 4096, dtype=jnp.int32)
    positions = offsets + jnp.arange(SEQ, dtype=jnp.int32)[None, :]
    return {
        "x": x,
        "positions": positions,
        "mix_norm": gain((DEPTH, D_MODEL)),
        "ffn_norm": gain((DEPTH, D_MODEL)),
        "ffn_gate": dense((DEPTH, D_MODEL, D_FF), D_MODEL),
        "ffn_up": dense((DEPTH, D_MODEL, D_FF), D_MODEL),
        "ffn_down": dense((DEPTH, D_FF, D_MODEL), D_FF),
        "w_in_even": dense((N_EVEN, D_MODEL, IN_EVEN), D_MODEL),
        "w_out_even": dense((N_EVEN, D_MODEL, D_MODEL), D_MODEL),
        "hgrn_lb_logits": jax.random.normal(next(ks), (N_EVEN + 1, HGRN_K), F32),
        "hgrn_gnorm": gain((N_EVEN, HGRN_V)),
        "sgu_ln_g": gain((N_EVEN, MIX_HALF)),
        "sgu_ln_b": bias((N_EVEN, MIX_HALF)),
        "sgu_w": 0.5 * dense((N_EVEN, SGU_GROUPS, SGU_CHUNK, SGU_CHUNK), SGU_CHUNK),
        "sgu_b": gain((N_EVEN, SGU_GROUPS, SGU_CHUNK)),
        "w_in_odd": dense((N_ODD, D_MODEL, IN_ODD), D_MODEL),
        "w_out_odd": dense((N_ODD, D_MODEL, D_MODEL), D_MODEL),
        "conv_w": dense((N_ODD, CONV_WIDTH, CONV_CH), CONV_WIDTH),
        "conv_b": bias((N_ODD, CONV_CH)),
        "conv_ln_g": gain((N_ODD, CONV_CH)),
        "conv_ln_b": bias((N_ODD, CONV_CH)),
        "mla_q_norm": gain((N_ODD, MLA_Q_RANK)),
        "mla_w_uq": dense((N_ODD, MLA_Q_RANK, MLA_HEADS * (MLA_NOPE + MLA_ROPE)), MLA_Q_RANK),
        "mla_kv_norm": gain((N_ODD, MLA_KV_RANK)),
        "mla_w_ukv": dense((N_ODD, MLA_KV_RANK, MLA_HEADS * (MLA_NOPE + MLA_V)), MLA_KV_RANK),
        "final_norm": gain((D_MODEL,)),
    }


def reference(x, positions, mix_norm, ffn_norm, ffn_gate, ffn_up, ffn_down,
              w_in_even, w_out_even, hgrn_lb_logits, hgrn_gnorm, sgu_ln_g, sgu_ln_b, sgu_w, sgu_b,
              w_in_odd, w_out_odd, conv_w, conv_b, conv_ln_g, conv_ln_b,
              mla_q_norm, mla_w_uq, mla_kv_norm, mla_w_ukv, final_norm):
    lower_bounds = jnp.cumsum(jax.nn.softmax(hgrn_lb_logits.astype(F32), axis=0), axis=0)
    even_splits = [HGRN_K, 2 * HGRN_K, 2 * HGRN_K + HGRN_V, 2 * HGRN_K + 2 * HGRN_V,
                   2 * HGRN_K + 2 * HGRN_V + MIX_HALF]
    odd_splits = [2 * CONV_CH, 2 * CONV_CH + MLA_Q_RANK, 2 * CONV_CH + MLA_Q_RANK + MLA_KV_RANK]
    for layer in range(DEPTH):
        j = layer // 2
        h = rmsnorm(x, mix_norm[layer])
        if layer % 2 == 0:
            p = h @ w_in_even[j]
            q, f_pre, i, g, u, v = jnp.split(p, even_splits, axis=-1)
            a_out = hgrn2(q, f_pre, i, g, lower_bounds[j], hgrn_gnorm[j])
            b_out = spatial_gating(jax.nn.gelu(u), jax.nn.gelu(v), sgu_ln_g[j], sgu_ln_b[j],
                                   sgu_w[j], sgu_b[j])
            x = x + jnp.concatenate([a_out, b_out], axis=-1) @ w_out_even[j]
        else:
            p = h @ w_in_odd[j]
            h_glu, c_q, c_kv, k_rope_pre = jnp.split(p, odd_splits, axis=-1)
            c_out = conformer_conv(h_glu, conv_w[j], conv_b[j], conv_ln_g[j], conv_ln_b[j])
            d_out = mla(c_q, c_kv, k_rope_pre, positions, mla_q_norm[j], mla_w_uq[j],
                        mla_kv_norm[j], mla_w_ukv[j])
            x = x + jnp.concatenate([c_out, d_out], axis=-1) @ w_out_odd[j]
        h = rmsnorm(x, ffn_norm[layer])
        x = x + swiglu(h, ffn_gate[layer], ffn_up[layer], ffn_down[layer])
    return rmsnorm(x, final_norm)
```

```cpp
#include <hip/hip_runtime.h>
#include <hip/hip_cooperative_groups.h>
#include <cstdio>
#include <cstdint>
namespace cg = cooperative_groups;
namespace pg8 {
#define PG8_LAS __attribute__((address_space(3)))
typedef unsigned short bf16_t;
typedef short bf16x8 __attribute__((ext_vector_type(8)));
typedef float f32x4 __attribute__((ext_vector_type(4)));
typedef unsigned u32x4 __attribute__((ext_vector_type(4)));
constexpr int BM = 256, BK = 64, HALF = 128, HTB = HALF * BK * 2  , STAGE_BYTES = 8 * HTB, NXCD = 8, WGM = 8;

__host__ __device__ __forceinline__ int lds_byte(int r, int c) { const int st = (r >> 4) * 2 + (c >> 5), rr = r & 15, cc = c & 31, ob = rr * 64 + cc * 2; return st * 1024 + (ob ^ (((ob >> 9) & 1) << 5)); }
__host__ __device__ __forceinline__ void stage_rc(int b, int& R, int& C) { const int st = b / 1024, sb = b % 1024, swz = sb ^ (((sb >> 9) & 1) << 5); R = (st >> 1) * 16 + swz / 64; C = (st & 1) * 32 + (swz % 64) / 2; }
__host__ __device__ __forceinline__ int perm32(int rho) { const int n = rho >> 4, i = rho & 15; return 8 * (i >> 2) + 4 * n + (i & 3); }

struct Unit { int pm, pn, idx; };
struct Gemm { const bf16_t* A; const bf16_t* Bt; int M, N, K, lda; };

struct StaticOrder {
    int nM, nN, nwg, G, c;
    __host__ __device__ void init(int M, int N, int G_, int c_) { nM = M / BM; nN = N / BM; nwg = nM * nN; G = G_; c = c_; }
    __host__ __device__ bool next(int i, Unit& u) const {
        const long L = (long)i * G + c; if (L >= nwg) return false;
        int wgid = (int)L; { const int q = nwg / NXCD, r = nwg % NXCD, xcd = wgid % NXCD, off = wgid / NXCD; wgid = (xcd < r ? xcd * (q + 1) : r * (q + 1) + (xcd - r) * q) + off; }
        const int nig = WGM * nN, gid = wgid / nig, fm = gid * WGM, gsz = (nM - fm) < WGM ? (nM - fm) : WGM;
        u.pm = fm + ((wgid % nig) % gsz); u.pn = (wgid % nig) / gsz; u.idx = i; return true;
    }
    __device__ __forceinline__ void a_ready(const Unit&) const {}
    __device__ __forceinline__ void done(const Unit&) const {}
};

__device__ __forceinline__ unsigned cvt_pk_bf16(float lo, float hi) { unsigned r; asm volatile("v_cvt_pk_bf16_f32 %0, %1, %2" : "=v"(r) : "v"(lo), "v"(hi)); return r; }
template <class Epi, class Sched, bool ALIGN_EPI = false, bool SP2 = false>
__device__ __forceinline__ void gemm_phase(PG8_LAS unsigned char* lds, const Gemm g, const Sched& S, const Epi& E) {
    const int tid = threadIdx.x, wid = __builtin_amdgcn_readfirstlane(tid >> 6), lane = tid & 63, wr = wid >> 2, wc = wid & 3, fr = lane & 15, fq = lane >> 4;
    const int K = g.K, nt = K / BK;
    unsigned voffA[2], voffB[2];
#pragma unroll
    for (int i = 0; i < 2; ++i) { int R, C; stage_rc(tid * 16 + i * 8192, R, C); const int Rb = Epi::PERM ? ((R & ~31) + perm32(R & 31)) : R;
        voffA[i] = (unsigned)(R * g.lda + C) * 2u; voffB[i] = (unsigned)(Rb * K + C) * 2u; }
    const size_t kstep = (size_t)(BK * 2);
    const size_t hstep = (size_t)HALF * K * 2;
    const size_t tstep = 2 * hstep; const size_t hstepA = (size_t)HALF * g.lda * 2; const size_t tstepA = 2 * hstepA;
    const unsigned ldsw = (unsigned)wid * 1024u;
    const int aoff = lds_byte(wr * 64 + fr, fq * 8), boff = lds_byte(wc * 32 + fr, fq * 8);
#define PG8_SA(b, h) (((b) * 2 + (h)) * HTB)
#define PG8_SB(b, h) ((4 + (b) * 2 + (h)) * HTB)
#define PG8_STAGE(bufoff, gbase, voff) do { _Pragma("unroll") for (int _i = 0; _i < 2; ++_i) \
        __builtin_amdgcn_global_load_lds((const unsigned*)((const char*)(gbase) + (voff)[_i]), (PG8_LAS unsigned*)(lds + (bufoff) + ldsw + _i * 8192), 16, 0, 0); } while (0)
#define PG8_LDA(dst, b, h) do { _Pragma("unroll") for (int m = 0; m < 4; ++m) _Pragma("unroll") for (int k = 0; k < 2; ++k) dst[m][k] = *(const PG8_LAS bf16x8*)(lds + PG8_SA(b, h) + aoff + m * 2048 + k * 1024); } while (0)
#define PG8_LDB(dst, b, h) do { _Pragma("unroll") for (int n = 0; n < 2; ++n) _Pragma("unroll") for (int k = 0; k < 2; ++k) dst[n][k] = *(const PG8_LAS bf16x8*)(lds + PG8_SB(b, h) + boff + n * 2048 + k * 1024); } while (0)
#define PG8_MMA(ai, bj, At, Bt) do { __builtin_amdgcn_s_setprio(1); _Pragma("unroll") for (int m = 0; m < 4; ++m) _Pragma("unroll") for (int n = 0; n < 2; ++n) _Pragma("unroll") for (int k = 0; k < 2; ++k) \
        acc[ai][bj][m][n] = __builtin_amdgcn_mfma_f32_16x16x32_bf16(Bt[n][k], At[m][k], acc[ai][bj][m][n], 0, 0, 0); __builtin_amdgcn_s_setprio(0); } while (0)
#define PG8_WAIT_V(n) asm volatile("s_waitcnt vmcnt(" #n ")" ::: "memory")
#define PG8_WAIT_L(n) asm volatile("s_waitcnt lgkmcnt(" #n ")" ::: "memory")
#define PG8_BAR __builtin_amdgcn_s_barrier()
#define PG8_SCHED __builtin_amdgcn_sched_barrier(0)
    Unit cur, nxt; int ui = 0;
    if (!S.next(0, cur)) return;
    f32x4 acc[2][2][4][2];
#pragma unroll
    for (int a = 0; a < 2; ++a)
#pragma unroll
        for (int b = 0; b < 2; ++b)
#pragma unroll
            for (int m = 0; m < 4; ++m)
#pragma unroll
                for (int n = 0; n < 2; ++n) acc[a][b][m][n] = (f32x4){0.f, 0.f, 0.f, 0.f};
    bf16x8 At[4][2], B0[2][2], B1[2][2];
    const char* cA = (const char*)g.A + (size_t)cur.pm * tstepA; const char* cB = (const char*)g.Bt + (size_t)cur.pn * tstep;
    S.a_ready(cur);
    if constexpr (SP2) {
        PG8_STAGE(PG8_SB(0, 0), cB, voffB); PG8_STAGE(PG8_SB(0, 1), cB + hstep, voffB); PG8_STAGE(PG8_SA(0, 0), cA, voffA); PG8_STAGE(PG8_SA(0, 1), cA + hstepA, voffA);
        if constexpr (Epi::RSTD_N > 0) E.pre(S);
        if (wr == 1) PG8_BAR;
        PG8_WAIT_V(2); PG8_BAR;
        PG8_STAGE(PG8_SB(1, 0), cB + kstep, voffB); PG8_STAGE(PG8_SA(1, 0), cA + kstep, voffA); PG8_STAGE(PG8_SB(1, 1), cB + hstep + kstep, voffB);
        PG8_WAIT_V(6); PG8_BAR;
    } else {
        PG8_STAGE(PG8_SB(0, 0), cB, voffB); PG8_STAGE(PG8_SA(0, 0), cA, voffA); PG8_STAGE(PG8_SB(0, 1), cB + hstep, voffB); PG8_STAGE(PG8_SA(0, 1), cA + hstepA, voffA);
        if (wr == 1) PG8_BAR;
        PG8_WAIT_V(4); PG8_BAR;
        PG8_STAGE(PG8_SB(1, 0), cB + kstep, voffB); PG8_STAGE(PG8_SA(1, 0), cA + kstep, voffA); PG8_STAGE(PG8_SB(1, 1), cB + hstep + kstep, voffB);
        PG8_WAIT_V(6); PG8_BAR;
    }
    for (;;) {
        const bool has_next = S.next(ui + 1, nxt);
        const char* nA = has_next ? (const char*)g.A + (size_t)nxt.pm * tstepA : cA; const char* nB = has_next ? (const char*)g.Bt + (size_t)nxt.pn * tstep : cB;
#pragma unroll 1
        for (int t = 0; t < nt; t += 2) {
            const bool last = (t == nt - 2);
            const char* a1 = cA + (size_t)(t + 1) * kstep;
            const char* a2 = last ? nA : cA + (size_t)(t + 2) * kstep; const char* b2 = last ? nB : cB + (size_t)(t + 2) * kstep;
            const char* a3 = a2 + kstep; const char* b3 = b2 + kstep;
            if (last && has_next) S.a_ready(nxt);
            if constexpr (SP2) {
            PG8_LDB(B0, 0, 0); PG8_LDB(B1, 0, 1); PG8_SCHED; PG8_LDA(At, 0, 0); PG8_STAGE(PG8_SA(1, 1), a1 + hstepA, voffA);
            PG8_WAIT_V(8); PG8_WAIT_L(0); PG8_BAR; PG8_MMA(0, 0, At, B0); PG8_MMA(0, 1, At, B1); PG8_BAR; PG8_SCHED;
            PG8_LDA(At, 0, 1); PG8_STAGE(PG8_SB(0, 0), b2, voffB); PG8_STAGE(PG8_SB(0, 1), b2 + hstep, voffB); PG8_STAGE(PG8_SA(0, 0), a2, voffA);
            PG8_WAIT_V(8); PG8_WAIT_L(0); PG8_BAR; PG8_MMA(1, 0, At, B0); PG8_MMA(1, 1, At, B1); PG8_BAR; PG8_SCHED;
            PG8_LDB(B0, 1, 0); PG8_LDB(B1, 1, 1); PG8_SCHED; PG8_LDA(At, 1, 0); PG8_STAGE(PG8_SA(0, 1), a2 + hstepA, voffA);
            PG8_WAIT_V(8); PG8_WAIT_L(0); PG8_BAR; PG8_MMA(0, 0, At, B0); PG8_MMA(0, 1, At, B1); PG8_BAR; PG8_SCHED;
            PG8_LDA(At, 1, 1); PG8_STAGE(PG8_SB(1, 0), b3, voffB); PG8_STAGE(PG8_SB(1, 1), b3 + hstep, voffB); PG8_STAGE(PG8_SA(1, 0), a3, voffA);
            PG8_WAIT_V(8); PG8_WAIT_L(0); PG8_BAR; PG8_MMA(1, 0, At, B0); PG8_MMA(1, 1, At, B1); PG8_BAR; PG8_SCHED;
            } else {
            PG8_LDB(B0, 0, 0); PG8_SCHED; PG8_LDA(At, 0, 0); PG8_STAGE(PG8_SA(1, 1), a1 + hstepA, voffA);
            PG8_WAIT_L(8); PG8_BAR; PG8_WAIT_L(0); PG8_MMA(0, 0, At, B0); PG8_BAR; PG8_SCHED;
            PG8_LDB(B1, 0, 1); PG8_STAGE(PG8_SB(0, 0), b2, voffB);
            PG8_BAR; PG8_WAIT_L(0); PG8_MMA(0, 1, At, B1); PG8_BAR;
            PG8_LDA(At, 0, 1); PG8_STAGE(PG8_SA(0, 0), a2, voffA);
            PG8_BAR; PG8_WAIT_L(0); PG8_MMA(1, 0, At, B0); PG8_BAR; PG8_SCHED;
            PG8_STAGE(PG8_SB(0, 1), b2 + hstep, voffB);
            PG8_WAIT_V(6); PG8_BAR; PG8_MMA(1, 1, At, B1); PG8_BAR;
            PG8_LDB(B0, 1, 0); PG8_SCHED; PG8_LDA(At, 1, 0); PG8_STAGE(PG8_SA(0, 1), a2 + hstepA, voffA);
            PG8_WAIT_L(8); PG8_BAR; PG8_WAIT_L(0); PG8_MMA(0, 0, At, B0); PG8_BAR; PG8_SCHED;
            PG8_LDB(B1, 1, 1); PG8_STAGE(PG8_SB(1, 0), b3, voffB);
            PG8_BAR; PG8_WAIT_L(0); PG8_MMA(0, 1, At, B1); PG8_BAR;
            PG8_LDA(At, 1, 1); PG8_STAGE(PG8_SA(1, 0), a3, voffA);
            PG8_BAR; PG8_WAIT_L(0); PG8_MMA(1, 0, At, B0); PG8_BAR; PG8_SCHED;
            PG8_STAGE(PG8_SB(1, 1), b3 + hstep, voffB);
            PG8_WAIT_V(6); PG8_BAR; PG8_MMA(1, 1, At, B1); PG8_BAR;
            }
        }
        if constexpr (ALIGN_EPI) { if (wr == 0) PG8_BAR; }
        if constexpr (!Epi::AFTER_DRAIN) { E(acc, cur, wr, wc, fr, fq); S.done(cur); }
        if (!has_next) break;
#pragma unroll
        for (int a = 0; a < 2; ++a)
#pragma unroll
            for (int b = 0; b < 2; ++b)
#pragma unroll
                for (int m = 0; m < 4; ++m)
#pragma unroll
                    for (int n = 0; n < 2; ++n) acc[a][b][m][n] = (f32x4){0.f, 0.f, 0.f, 0.f};
        cur = nxt; cA = nA; cB = nB; ++ui;
        if constexpr (ALIGN_EPI) { if (wr == 1) PG8_BAR; }
    }
    PG8_WAIT_V(0);
    if constexpr (!ALIGN_EPI) { if (wr == 0) PG8_BAR; }
    PG8_BAR;
    if constexpr (Epi::AFTER_DRAIN) { E.fused(acc, cur, wr, wc, fr, fq, lds, wid, lane); S.done(cur); }
#undef PG8_SA
#undef PG8_SB
#undef PG8_STAGE
#undef PG8_LDA
#undef PG8_LDB
#undef PG8_MMA
#undef PG8_WAIT_V
#undef PG8_WAIT_L
#undef PG8_BAR
#undef PG8_SCHED
}
}

using pg8::bf16_t; using pg8::bf16x8; using pg8::f32x4; using pg8::u32x4;
#define LAS __attribute__((address_space(3)))
typedef unsigned u32x2 __attribute__((ext_vector_type(2)));

constexpr int MTOK = 32768, DM = 1024, SEQ = 2048, NBATCH = 16, FF = 2816;
constexpr float EPS = 1e-6f;
constexpr int LDS_BYTES = 147456;

constexpr size_t WS_W_IN0  = 0;
constexpr size_t WS_W_OUT0 = WS_W_IN0  + (size_t)3072 * 1024 * 2;
constexpr size_t WS_W_GU0  = WS_W_OUT0 + (size_t)1024 * 1024 * 2;
constexpr size_t WS_W_D0   = WS_W_GU0  + (size_t)5632 * 1024 * 2;
constexpr size_t WS_W_IN1  = WS_W_D0   + (size_t)1024 * 2816 * 2;
constexpr size_t WS_W_OUT1 = WS_W_IN1  + (size_t)1792 * 1024 * 2;
constexpr size_t WS_W_GU1  = WS_W_OUT1 + (size_t)1024 * 1024 * 2;
constexpr size_t WS_W_D1   = WS_W_GU1  + (size_t)5632 * 1024 * 2;
constexpr size_t WS_W_UQ   = WS_W_D1   + (size_t)1024 * 2816 * 2;
constexpr size_t WS_W_UKV  = WS_W_UQ   + (size_t)768 * 384 * 2;
constexpr size_t WS_SS     = WS_W_UKV  + (size_t)1024 * 256 * 2;
constexpr size_t WS_ROPE   = WS_SS     + (size_t)7 * MTOK * 4;
constexpr size_t WS_XB     = WS_ROPE   + (size_t)MTOK * 64 * 4;
constexpr size_t WS_CAT    = WS_XB     + (size_t)MTOK * 1024 * 2;
constexpr size_t WS_R1     = WS_CAT    + (size_t)MTOK * 1024 * 2;
constexpr size_t R1_BYTES  = (size_t)220 * 1024 * 1024;
constexpr size_t WS_BAR    = WS_R1 + R1_BYTES;
constexpr size_t WS_END    = WS_BAR + 16384;
constexpr size_t R1_HGLU = 0;
constexpr size_t R1_PQKV = R1_HGLU + (size_t)MTOK * 512 * 2;
constexpr size_t R1_Q    = R1_PQKV + (size_t)MTOK * 768 * 2;
constexpr size_t R1_KB   = R1_Q    + (size_t)MTOK * 768 * 2;
constexpr size_t R1_VT   = R1_KB   + (size_t)MTOK * 4 * 192 * 2;
static_assert(R1_VT + (size_t)MTOK * 512 * 2 <= R1_BYTES, "R1 too small");
static_assert((size_t)MTOK * 3072 * 2 <= R1_BYTES, "R1 too small for p_even");

struct Args { const float* in[26]; float* out; unsigned char* ws; int ph_lo, ph_hi; };

__device__ __forceinline__ float bf2f(bf16_t b) { return __uint_as_float((unsigned)b << 16); }
__device__ __forceinline__ float bflo(unsigned u) { return __uint_as_float(u << 16); }
__device__ __forceinline__ float bfhi(unsigned u) { return __uint_as_float(u & 0xffff0000u); }
__device__ __forceinline__ unsigned pk2(float lo, float hi) { return pg8::cvt_pk_bf16(lo, hi); }
__device__ __forceinline__ bf16_t f2bf(float f) { return (bf16_t)(pk2(f, 0.f) & 0xffffu); }
__device__ __forceinline__ float sigmoidf_(float x) { return __builtin_amdgcn_rcpf(1.0f + __expf(-x)); }
__device__ __forceinline__ float siluf_(float x) { return x * sigmoidf_(x); }
__device__ __forceinline__ float gelu_tanh(float x) { const float z = 1.5957691216057308f * (x + 0.044715f * x * x * x); return x * sigmoidf_(z); }
__device__ __forceinline__ void wg_barrier() { __syncthreads(); }
typedef unsigned u32x2s __attribute__((ext_vector_type(2)));
__device__ __forceinline__ float xor32_max(float x) { const u32x2s r = __builtin_amdgcn_permlane32_swap(__float_as_uint(x), __float_as_uint(x), false, false); return __builtin_fmaxf(__uint_as_float(r.x), __uint_as_float(r.y)); }
__device__ __forceinline__ float xor16_max(float x) { const u32x2s r = __builtin_amdgcn_permlane16_swap(__float_as_uint(x), __float_as_uint(x), false, false); return __builtin_fmaxf(__uint_as_float(r.x), __uint_as_float(r.y)); }
__device__ __forceinline__ f32x4 mfma16(bf16x8 a, bf16x8 b, f32x4 c) { return __builtin_amdgcn_mfma_f32_16x16x32_bf16(a, b, c, 0, 0, 0); }
__device__ __forceinline__ bf16x8 lds_frag(LAS unsigned char* base, int byte_off) { return *(const LAS bf16x8*)(base + byte_off); }

struct EpiInEven {
    static constexpr bool PERM = true, AFTER_DRAIN = false; static constexpr int RSTD_N = 1024; LAS float* rt; const float* ssrc;
    template <class Sched> __device__ __forceinline__ void pre(const Sched& S) const { pg8::Unit u; for (int i = 0; i < 15 && S.next(i, u); ++i) if (threadIdx.x < 256) rt[i * 256 + threadIdx.x] = rsqrtf(ssrc[u.pm * 256 + threadIdx.x] * (1.0f / (float)RSTD_N) + EPS); }
    bf16_t* O; const float* ss;
    __device__ __forceinline__ void operator()(const f32x4 (&acc)[2][2][4][2], const pg8::Unit& u, int wr, int wc, int fr, int fq) const {
        const int row0 = u.pm * 256 + wr * 64 + fr, col0 = u.pn * 256 + wc * 32 + 8 * fq; const bool act = u.pn >= 8;
#pragma unroll
        for (int ai = 0; ai < 2; ++ai)
#pragma unroll
            for (int m = 0; m < 4; ++m) { const int row = row0 + ai * 128 + m * 16; const float rstd = rt[u.idx * 256 + (row - u.pm * 256)];
#pragma unroll
                for (int bj = 0; bj < 2; ++bj) { f32x4 v0 = acc[ai][bj][m][0] * rstd, v1 = acc[ai][bj][m][1] * rstd;
                    if (act) {
#pragma unroll
                        for (int j = 0; j < 4; ++j) { v0[j] = gelu_tanh(v0[j]); v1[j] = gelu_tanh(v1[j]); } }
                    u32x4 w; w.x = pk2(v0[0], v0[1]); w.y = pk2(v0[2], v0[3]); w.z = pk2(v1[0], v1[1]); w.w = pk2(v1[2], v1[3]);
                    __builtin_nontemporal_store(w, (u32x4*)(O + (size_t)row * 3072 + col0 + bj * 128)); } }
    }
};
struct EpiResid {
    static constexpr bool PERM = true, AFTER_DRAIN = false; static constexpr int RSTD_N = 0;
    bf16_t* xb; float* ss;
    __device__ __forceinline__ void operator()(const f32x4 (&acc)[2][2][4][2], const pg8::Unit& u, int wr, int wc, int fr, int fq) const {
        const int row0 = u.pm * 256 + wr * 64 + fr, col0 = u.pn * 256 + wc * 32 + 8 * fq;
#pragma unroll
        for (int ai = 0; ai < 2; ++ai) {
            u32x4 r[4][2];
#pragma unroll
            for (int m = 0; m < 4; ++m)
#pragma unroll
                for (int bj = 0; bj < 2; ++bj) r[m][bj] = *(const u32x4*)(xb + (size_t)(row0 + ai * 128 + m * 16) * 1024 + col0 + bj * 128);
#pragma unroll
            for (int m = 0; m < 4; ++m) { const int row = row0 + ai * 128 + m * 16; bf16_t* xp = xb + (size_t)row * 1024 + col0; float s = 0.f;
#pragma unroll
                for (int bj = 0; bj < 2; ++bj) { const u32x4 q = r[m][bj];
                    u32x4 w; w.x = pk2(bflo(q.x) + acc[ai][bj][m][0][0], bfhi(q.x) + acc[ai][bj][m][0][1]); w.y = pk2(bflo(q.y) + acc[ai][bj][m][0][2], bfhi(q.y) + acc[ai][bj][m][0][3]);
                    w.z = pk2(bflo(q.z) + acc[ai][bj][m][1][0], bfhi(q.z) + acc[ai][bj][m][1][1]); w.w = pk2(bflo(q.w) + acc[ai][bj][m][1][2], bfhi(q.w) + acc[ai][bj][m][1][3]);
                    __builtin_nontemporal_store(w, (u32x4*)(xp + bj * 128));
                    s += (bflo(w.x) * bflo(w.x) + bfhi(w.x) * bfhi(w.x)) + (bflo(w.y) * bflo(w.y) + bfhi(w.y) * bfhi(w.y)) + (bflo(w.z) * bflo(w.z) + bfhi(w.z) * bfhi(w.z)) + (bflo(w.w) * bflo(w.w) + bfhi(w.w) * bfhi(w.w)); }
                s += __shfl_xor(s, 16); s += __shfl_xor(s, 32);
                if (fq == 0) unsafeAtomicAdd(ss + row, s); }
        }
    }
};
struct EpiSwiglu {
    static constexpr bool PERM = true, AFTER_DRAIN = false; static constexpr int RSTD_N = 1024; LAS float* rt; const float* ssrc;
    template <class Sched> __device__ __forceinline__ void pre(const Sched& S) const { pg8::Unit u; for (int i = 0; i < 15 && S.next(i, u); ++i) if (threadIdx.x < 256) rt[i * 256 + threadIdx.x] = rsqrtf(ssrc[u.pm * 256 + threadIdx.x] * (1.0f / (float)RSTD_N) + EPS); }
    bf16_t* O; const float* ss;
    __device__ __forceinline__ void operator()(const f32x4 (&acc)[2][2][4][2], const pg8::Unit& u, int wr, int wc, int fr, int fq) const {
        const int row0 = u.pm * 256 + wr * 64 + fr, col0 = u.pn * 128 + wc * 32 + 8 * fq;
#pragma unroll
        for (int ai = 0; ai < 2; ++ai)
#pragma unroll
            for (int m = 0; m < 4; ++m) { const int row = row0 + ai * 128 + m * 16; const float rstd = rt[u.idx * 256 + (row - u.pm * 256)];
                float h[8];
#pragma unroll
                for (int n = 0; n < 2; ++n)
#pragma unroll
                    for (int j = 0; j < 4; ++j) { const float gv = acc[ai][0][m][n][j] * rstd, uv = acc[ai][1][m][n][j] * rstd; h[n * 4 + j] = siluf_(gv) * uv; }
                u32x4 w; w.x = pk2(h[0], h[1]); w.y = pk2(h[2], h[3]); w.z = pk2(h[4], h[5]); w.w = pk2(h[6], h[7]);
                __builtin_nontemporal_store(w, (u32x4*)(O + (size_t)row * FF + col0)); }
    }
};
struct EpiInOdd {
    static constexpr bool PERM = true, AFTER_DRAIN = false; static constexpr int RSTD_N = 1024; LAS float* rt; const float* ssrc;
    template <class Sched> __device__ __forceinline__ void pre(const Sched& S) const { pg8::Unit u; for (int i = 0; i < 15 && S.next(i, u); ++i) if (threadIdx.x < 256) rt[i * 256 + threadIdx.x] = rsqrtf(ssrc[u.pm * 256 + threadIdx.x] * (1.0f / (float)RSTD_N) + EPS); }
    bf16_t* hglu; bf16_t* pqkv; const float* ss; float* ssq; float* sskv; int thr, off0, off1;
    __device__ __forceinline__ void operator()(const f32x4 (&acc)[2][2][4][2], const pg8::Unit& u, int wr, int wc, int fr, int fq) const {
        const int row0 = u.pm * 256 + wr * 64 + fr; const int lpn = u.pn < thr ? u.pn + off0 : u.pn + off1;
#pragma unroll
        for (int ai = 0; ai < 2; ++ai)
#pragma unroll
            for (int m = 0; m < 4; ++m) { const int row = row0 + ai * 128 + m * 16; const float rstd = rt[u.idx * 256 + (row - u.pm * 256)];
                if (lpn < 4) {
                    float h[8];
#pragma unroll
                    for (int n = 0; n < 2; ++n)
#pragma unroll
                        for (int j = 0; j < 4; ++j) { const float av = acc[ai][0][m][n][j] * rstd, gv = acc[ai][1][m][n][j] * rstd; h[n * 4 + j] = av * sigmoidf_(gv); }
                    u32x4 w; w.x = pk2(h[0], h[1]); w.y = pk2(h[2], h[3]); w.z = pk2(h[4], h[5]); w.w = pk2(h[6], h[7]);
                    __builtin_nontemporal_store(w, (u32x4*)(hglu + (size_t)row * 512 + lpn * 128 + wc * 32 + 8 * fq));
                } else {
                    const int t = lpn - 4;
#pragma unroll
                    for (int bj = 0; bj < 2; ++bj) { const f32x4 v0 = acc[ai][bj][m][0] * rstd, v1 = acc[ai][bj][m][1] * rstd;
                        u32x4 w; w.x = pk2(v0[0], v0[1]); w.y = pk2(v0[2], v0[3]); w.z = pk2(v1[0], v1[1]); w.w = pk2(v1[2], v1[3]);
                        __builtin_nontemporal_store(w, (u32x4*)(pqkv + (size_t)row * 768 + t * 256 + bj * 128 + wc * 32 + 8 * fq));
                        const int which = t * 2 + bj;
                        if (which < 5) { float s = (v0[0] * v0[0] + v0[1] * v0[1]) + (v0[2] * v0[2] + v0[3] * v0[3]) + (v1[0] * v1[0] + v1[1] * v1[1]) + (v1[2] * v1[2] + v1[3] * v1[3]);
                            s += __shfl_xor(s, 16); s += __shfl_xor(s, 32);
                            if (fq == 0) unsafeAtomicAdd((which < 3 ? ssq : sskv) + row, s); } } } }
    }
};
constexpr float QSCALE = 0.07216878364870322f * 1.4426950408889634f;
struct EpiUq {
    static constexpr bool PERM = true, AFTER_DRAIN = false; static constexpr int RSTD_N = 384; LAS float* rt; const float* ssrc;
    template <class Sched> __device__ __forceinline__ void pre(const Sched& S) const { pg8::Unit u; for (int i = 0; i < 15 && S.next(i, u); ++i) if (threadIdx.x < 256) rt[i * 256 + threadIdx.x] = rsqrtf(ssrc[u.pm * 256 + threadIdx.x] * (1.0f / (float)RSTD_N) + EPS); }
    bf16_t* Q; const float* ssq;
    __device__ __forceinline__ void operator()(const f32x4 (&acc)[2][2][4][2], const pg8::Unit& u, int wr, int wc, int fr, int fq) const {
        const int row0 = u.pm * 256 + wr * 64 + fr, col0 = u.pn * 256 + wc * 32 + 8 * fq;
#pragma unroll
        for (int ai = 0; ai < 2; ++ai)
#pragma unroll
            for (int m = 0; m < 4; ++m) { const int row = row0 + ai * 128 + m * 16; const float rstd = rt[u.idx * 256 + (row - u.pm * 256)] * QSCALE;
#pragma unroll
                for (int bj = 0; bj < 2; ++bj) { const f32x4 v0 = acc[ai][bj][m][0] * rstd, v1 = acc[ai][bj][m][1] * rstd;
                    u32x4 w; w.x = pk2(v0[0], v0[1]); w.y = pk2(v0[2], v0[3]); w.z = pk2(v1[0], v1[1]); w.w = pk2(v1[2], v1[3]);
                    __builtin_nontemporal_store(w, (u32x4*)(Q + (size_t)row * 768 + col0 + bj * 128)); } }
    }
};
struct EpiUkv {
    static constexpr bool PERM = true, AFTER_DRAIN = false; static constexpr int RSTD_N = 256; LAS float* rt; const float* ssrc;
    template <class Sched> __device__ __forceinline__ void pre(const Sched& S) const { pg8::Unit u; for (int i = 0; i < 15 && S.next(i, u); ++i) if (threadIdx.x < 256) rt[i * 256 + threadIdx.x] = rsqrtf(ssrc[u.pm * 256 + threadIdx.x] * (1.0f / (float)RSTD_N) + EPS); }
    bf16_t* Kb; bf16_t* Vt; const float* sskv;
    __device__ __forceinline__ void operator()(const f32x4 (&acc)[2][2][4][2], const pg8::Unit& u, int wr, int wc, int fr, int fq) const {
        const int row0 = u.pm * 256 + wr * 64 + fr, h = u.pn;
#pragma unroll
        for (int ai = 0; ai < 2; ++ai)
#pragma unroll
            for (int m = 0; m < 4; ++m) { const int row = row0 + ai * 128 + m * 16; const float rstd = rt[u.idx * 256 + (row - u.pm * 256)];
                const int b = row >> 11, t = row & 2047; const size_t bh = (size_t)(b * 4 + h);
                { const f32x4 v0 = acc[ai][0][m][0] * rstd, v1 = acc[ai][0][m][1] * rstd;
                  u32x4 w; w.x = pk2(v0[0], v0[1]); w.y = pk2(v0[2], v0[3]); w.z = pk2(v1[0], v1[1]); w.w = pk2(v1[2], v1[3]);
                  __builtin_nontemporal_store(w, (u32x4*)(Kb + (bh * 2048 + t) * 192 + wc * 32 + 8 * fq)); }
{ const f32x4 v0 = acc[ai][1][m][0] * rstd, v1 = acc[ai][1][m][1] * rstd;
                  u32x4 w; w.x = pk2(v0[0], v0[1]); w.y = pk2(v0[2], v0[3]); w.z = pk2(v1[0], v1[1]); w.w = pk2(v1[2], v1[3]);
                  __builtin_nontemporal_store(w, (u32x4*)(Vt + (bh * 2048 + t) * 128 + wc * 32 + 8 * fq)); } }
    }
};

struct EpiNull {
    static constexpr bool PERM = true, AFTER_DRAIN = false; static constexpr int RSTD_N = 0;
    float* sink;
    __device__ __forceinline__ void operator()(const f32x4 (&acc)[2][2][4][2], const pg8::Unit& u, int wr, int wc, int fr, int fq) const {
        f32x4 s = (f32x4){0.f, 0.f, 0.f, 0.f};
#pragma unroll
        for (int ai = 0; ai < 2; ++ai)
#pragma unroll
            for (int bj = 0; bj < 2; ++bj)
#pragma unroll
                for (int m = 0; m < 4; ++m) { s += acc[ai][bj][m][0]; s += acc[ai][bj][m][1]; }
        if (s[0] + s[1] + s[2] + s[3] == 12345.678f) sink[0] = 1.f;
    }
};
struct ListOrder {
    int nM, nN, first, cnt;
    __device__ bool next(int i, pg8::Unit& u) const {
        if (i >= cnt) return false;
        const int wgid = first + i, nig = pg8::WGM * nN, gid = wgid / nig, fm = gid * pg8::WGM, gsz = (nM - fm) < pg8::WGM ? (nM - fm) : pg8::WGM;
        u.pm = fm + ((wgid % nig) % gsz); u.pn = (wgid % nig) / gsz; u.idx = i; return true;
    }
    __device__ __forceinline__ void a_ready(const pg8::Unit&) const {}
    __device__ __forceinline__ void done(const pg8::Unit&) const {}
};
template <class Epi, class Sched>
__device__ __forceinline__ void run_gemm_s(LAS unsigned char* lds, const bf16_t* A, int lda, const bf16_t* Bt, int N, int K, Epi E, const Sched& S) {
    pg8::Gemm g; g.A = A; g.Bt = Bt; g.M = MTOK; g.N = N; g.K = K; g.lda = lda;
    if constexpr (Epi::RSTD_N > 0) E.rt = (LAS float*)(lds + pg8::STAGE_BYTES);
    pg8::gemm_phase<Epi, Sched, true, true>(lds, g, S, E);
}
template <class Epi>
__device__ __forceinline__ void run_gemm(LAS unsigned char* lds, const bf16_t* A, int lda, const bf16_t* Bt, int N, int K, Epi E, int stagger = 0) {
    pg8::Gemm g; g.A = A; g.Bt = Bt; g.M = MTOK; g.N = N; g.K = K; g.lda = lda;
    pg8::StaticOrder S; S.init(MTOK, N, (int)gridDim.x, (int)blockIdx.x);
    if constexpr (Epi::RSTD_N > 0) E.rt = (LAS float*)(lds + pg8::STAGE_BYTES);
    pg8::gemm_phase<Epi, pg8::StaticOrder, true, true>(lds, g, S, E);
}
#define XB_TMO      128
#define XB_XCNT(j)  (256  + 64 * (j))
#define XB_XSUB(j)  (1280 + 64 * (j))
#define XB_XGEN(j)  (2304 + 64 * (j))
#define XB_TOP      3328
#define XB_TOPGEN   3392
#define XCD_BAR_WORDS 3456
#define XB_SPIN_CAP (1u << 18)

__device__ __forceinline__ unsigned xb_ld(unsigned* p)              { return __hip_atomic_load(p, __ATOMIC_RELAXED, __HIP_MEMORY_SCOPE_AGENT); }
__device__ __forceinline__ unsigned xb_add(unsigned* p, unsigned v) { return __hip_atomic_fetch_add(p, v, __ATOMIC_RELAXED, __HIP_MEMORY_SCOPE_AGENT); }
__device__ __forceinline__ unsigned xb_xcc_id() { return (unsigned)__builtin_amdgcn_s_getreg((3 << 11) | 20) & 0xFu; }
#define XB_SPIN(cond, bar) do { unsigned _sp = 0; while (cond) { __builtin_amdgcn_s_sleep(1); \
    if ((++_sp & 255u) == 0u) { if (xb_ld(&(bar)[XB_TMO])) break; if (_sp > XB_SPIN_CAP) { atomicAdd(&(bar)[XB_TMO], 1u); break; } } } } while (0)

struct XcdBarrier {
    unsigned* bar; unsigned x;
    volatile LAS unsigned* st;
};

__device__ __forceinline__ XcdBarrier xcd_barrier_post(unsigned* bar, volatile LAS unsigned* st) {
    XcdBarrier b; b.bar = bar; b.x = xb_xcc_id(); b.st = st;
    if (threadIdx.x == 0) (void)xb_add(&bar[XB_XCNT(b.x)], 1u);
    return b;
}
__device__ __forceinline__ void xcd_barrier_complete(unsigned* bar, unsigned x, unsigned& nloc, unsigned& nx) {
    const unsigned G = gridDim.x * gridDim.y * gridDim.z;
    unsigned sum, cnt, mine, sp = 0u;
    for (;;) {
        sum = 0u; cnt = 0u; mine = 0u;
#pragma unroll
        for (unsigned j = 0; j < 16; ++j) { const unsigned c = xb_ld(&bar[XB_XCNT(j)]); sum += c; cnt += (c > 0u) ? 1u : 0u; mine = (j == x) ? c : mine; }
        if (sum == G) break;
        __builtin_amdgcn_s_sleep(1);
        if ((++sp & 255u) == 0u) { if (xb_ld(&bar[XB_TMO])) break; if (sp > XB_SPIN_CAP) { atomicAdd(&bar[XB_TMO], 1u); break; } }
    }
    nloc = mine > 0u ? mine : 1u; nx = cnt > 0u ? cnt : 1u;
}

__device__ __forceinline__ void xcd_barrier(const XcdBarrier& b) {
    asm volatile("s_waitcnt vmcnt(0)" ::: "memory");
    __syncthreads();
    if (threadIdx.x == 0) {
        unsigned* bar = b.bar;
        __builtin_amdgcn_s_waitcnt(0);
        unsigned nloc = b.st[0], nx = b.st[1];
        if (nloc == 0u) { xcd_barrier_complete(bar, b.x, nloc, nx); b.st[0] = nloc; b.st[1] = nx; }
        const unsigned old = xb_add(&bar[XB_XSUB(b.x)], 1u);
        const unsigned gen = old / nloc;
        if (old + 1u == (gen + 1u) * nloc) {
            __builtin_amdgcn_fence(__ATOMIC_RELEASE, "agent");
            asm volatile("s_waitcnt vmcnt(0)" ::: "memory");
            const unsigned og = xb_add(&bar[XB_TOP], 1u);
            const unsigned tg = og / nx;
            if (og + 1u == (tg + 1u) * nx) xb_add(&bar[XB_TOPGEN], 1u);
            else XB_SPIN(xb_ld(&bar[XB_TOPGEN]) == tg, bar);
            __builtin_amdgcn_fence(__ATOMIC_ACQUIRE, "agent");
            xb_add(&bar[XB_XGEN(b.x)], 1u);
            asm volatile("s_waitcnt vmcnt(0)" ::: "memory");
        } else {
            XB_SPIN(xb_ld(&bar[XB_XGEN(b.x)]) == gen, bar);
            __builtin_amdgcn_fence(__ATOMIC_ACQUIRE, "agent");
            asm volatile("s_waitcnt vmcnt(0)" ::: "memory");
        }
    }
    __syncthreads();
}

__device__ __forceinline__ void tr_item(const float* W, int ld, int col0, int k0, const float* gain, bf16_t* WT, int K, int nrow0, LAS float* scr, int lane) {
    const float keep = col0 >= 0 ? 1.0f : 0.0f; const int colc = col0 >= 0 ? col0 : 0; const int c = lane & 7;
    f32x4 g0 = (f32x4){keep, keep, keep, keep}, g1 = g0;
    if (gain) { g0 = *(const f32x4*)(gain + k0 + 8 * c) * keep; g1 = *(const f32x4*)(gain + k0 + 8 * c + 4) * keep; }
#pragma unroll 8
    for (int i = 0; i < 32; ++i) { const int kk = 2 * i + (lane >> 5); scr[kk * 33 + (lane & 31)] = W[(size_t)(k0 + kk) * ld + colc + (lane & 31)]; }
    asm volatile("s_waitcnt lgkmcnt(0)" ::: "memory");
#pragma unroll
    for (int j = 0; j < 4; ++j) { const int n = (lane >> 3) + 8 * j; const LAS float* s = scr + (8 * c) * 33 + n;
        u32x4 o; o.x = pk2(s[0 * 33] * g0[0], s[1 * 33] * g0[1]); o.y = pk2(s[2 * 33] * g0[2], s[3 * 33] * g0[3]); o.z = pk2(s[4 * 33] * g1[0], s[5 * 33] * g1[1]); o.w = pk2(s[6 * 33] * g1[2], s[7 * 33] * g1[3]);
        *(u32x4*)(WT + (size_t)(nrow0 + n) * K + k0 + 8 * c) = o; }
    asm volatile("s_waitcnt lgkmcnt(0)" ::: "memory");
}
__device__ __forceinline__ void convert_weights(const Args& a, LAS unsigned char* lds, int lo, int hi, int gw, int NGW) {
    const int tid = threadIdx.x, wid = tid >> 6, lane = tid & 63;
    unsigned char* ws = a.ws;
    LAS float* scr = (LAS float*)(lds + wid * 8704);
    constexpr int I0 = 1536, I1 = 512, I2 = 2816, I3 = 1408, I4 = 896, I5 = 512, I6 = 2816, I7 = 1408, I8 = 144, I9 = 128;
    for (int it = lo + gw; it < hi; it += NGW) {
        int r = it;
        if (r < I0) { const int kb = r / 96, nb = r % 96; tr_item(a.in[7], 3072, nb * 32, kb * 64, a.in[2], (bf16_t*)(ws + WS_W_IN0), 1024, nb * 32, scr, lane); continue; } r -= I0;
        if (r < I1) { const int kb = r / 32, nb = r % 32; tr_item(a.in[8], 1024, nb * 32, kb * 64, nullptr, (bf16_t*)(ws + WS_W_OUT0), 1024, nb * 32, scr, lane); continue; } r -= I1;
        if (r < I2) { const int kb = r / 176, nb = r % 176, n0 = nb * 32, tile = n0 >> 8, rr = n0 & 255;
            tr_item(rr < 128 ? a.in[4] : a.in[5], FF, tile * 128 + (rr & 127), kb * 64, a.in[3], (bf16_t*)(ws + WS_W_GU0), 1024, n0, scr, lane); continue; } r -= I2;
        if (r < I3) { const int kb = r / 32, nb = r % 32; tr_item(a.in[6], 1024, nb * 32, kb * 64, nullptr, (bf16_t*)(ws + WS_W_D0), FF, nb * 32, scr, lane); continue; } r -= I3;
        if (r < I4) { const int kb = r / 56, nb = r % 56, n0 = nb * 32; int col;
            { const int pt = n0 >> 8, rr = n0 & 255, lt = pt < 3 ? pt : (pt < 6 ? pt + 1 : 3), ln = lt * 256 + rr;
              if (lt < 4) col = rr < 128 ? lt * 128 + rr : 512 + lt * 128 + (rr - 128); else col = ln < 1728 ? ln : -1; }
            tr_item(a.in[15], 1728, col, kb * 64, a.in[2] + 1024, (bf16_t*)(ws + WS_W_IN1), 1024, n0, scr, lane); continue; } r -= I4;
        if (r < I5) { const int kb = r / 32, nb = r % 32; tr_item(a.in[16], 1024, nb * 32, kb * 64, nullptr, (bf16_t*)(ws + WS_W_OUT1), 1024, nb * 32, scr, lane); continue; } r -= I5;
        if (r < I6) { const int kb = r / 176, nb = r % 176, n0 = nb * 32, tile = n0 >> 8, rr = n0 & 255;
            tr_item((rr < 128 ? a.in[4] : a.in[5]) + (size_t)1024 * FF, FF, tile * 128 + (rr & 127), kb * 64, a.in[3] + 1024, (bf16_t*)(ws + WS_W_GU1), 1024, n0, scr, lane); continue; } r -= I6;
        if (r < I7) { const int kb = r / 32, nb = r % 32; tr_item(a.in[6] + (size_t)FF * 1024, 1024, nb * 32, kb * 64, nullptr, (bf16_t*)(ws + WS_W_D1), FF, nb * 32, scr, lane); continue; } r -= I7;
        if (r < I8) { const int kb = r / 24, nb = r % 24; tr_item(a.in[22], 768, nb * 32, kb * 64, a.in[21], (bf16_t*)(ws + WS_W_UQ), 384, nb * 32, scr, lane); continue; } r -= I8;
        { const int kb = r / 32, nb = r % 32; tr_item(a.in[24], 1024, nb * 32, kb * 64, a.in[23], (bf16_t*)(ws + WS_W_UKV), 256, nb * 32, scr, lane); }
    }
}
constexpr int WCONV_FIRST = 1536, WCONV_ALL = 1536 + 512 + 2816 + 1408 + 896 + 512 + 2816 + 1408 + 144 + 128;
__device__ __forceinline__ void phase_prologue(const Args& a, LAS unsigned char* lds) {
    const int tid = threadIdx.x, wid = tid >> 6, lane = tid & 63;
    const int gw = blockIdx.x * 8 + wid, NGW = gridDim.x * 8;
    unsigned char* ws = a.ws;
    convert_weights(a, lds, 0, WCONV_ALL, gw, NGW);
    float* ss = (float*)(ws + WS_SS);
    bf16_t* xb = (bf16_t*)(ws + WS_XB);
    for (int row0 = gw; row0 < MTOK; row0 += 4 * NGW) {
        f32x4 v[4][4];
#pragma unroll
        for (int r = 0; r < 4; ++r) { const int row = (row0 + r * NGW < MTOK) ? row0 + r * NGW : row0; const f32x4* xr = (const f32x4*)(a.in[0] + (size_t)row * 1024) + lane;
#pragma unroll
            for (int j = 0; j < 4; ++j) v[r][j] = __builtin_nontemporal_load(xr + 64 * j); }
#pragma unroll
        for (int r = 0; r < 4; ++r) { const int row = row0 + r * NGW; if (row < MTOK) { u32x2* o = (u32x2*)(xb + (size_t)row * 1024) + lane; float s = 0.f;
#pragma unroll
            for (int j = 0; j < 4; ++j) { const f32x4 x = v[r][j]; s += (x[0] * x[0] + x[1] * x[1]) + (x[2] * x[2] + x[3] * x[3]); u32x2 w; w.x = pk2(x[0], x[1]); w.y = pk2(x[2], x[3]); o[64 * j] = w; }
#pragma unroll
            for (int off = 1; off < 64; off <<= 1) s += __shfl_xor(s, off);
            if (lane == 0) ss[row] = s; } }
    }
    { f32x4* z = (f32x4*)(ss + MTOK); const int n4 = 6 * MTOK / 4; for (int i = blockIdx.x * 512 + tid; i < n4; i += gridDim.x * 512) z[i] = (f32x4){0.f, 0.f, 0.f, 0.f}; }
    { float* rope = (float*)(ws + WS_ROPE); const int* pos = (const int*)a.in[1];
      for (int i = blockIdx.x * 512 + tid; i < MTOK * 32; i += gridDim.x * 512) { const int tok = i >> 5, k = i & 31;
          const float inv = 1.0f / exp2f((float)k * 0.41524101186092029f);
          const float ang = (float)pos[tok] * inv;
          const double rr = (double)ang * 0.15915494309189535; const float fr_ = (float)(rr - rint(rr)) * 6.283185307179586f;
          rope[(size_t)tok * 64 + k] = cosf(fr_); rope[(size_t)tok * 64 + 32 + k] = sinf(fr_); } }
}

constexpr int HG_QI = 0, HG_KI = 17408, HG_QH = 34816, HG_KT = 52224, HG_IT = 70656, HG_PP = 89088, HG_ST = 98304, HG_REF = 133120, HG_TOT = 135680, HG_SS = 137728;
static_assert(HG_SS + 512 <= LDS_BYTES, "hgrn lds");
constexpr size_t HGS_QH = 0, HGS_KT = 16384, HGS_IT = 32768, HGS_PP = 49152, HGS_DEC = 57344, HGS_STRIDE = 57856;
static_assert(HGS_STRIDE * 2048 <= (size_t)MTOK * 1024 * 4, "hgrn scratch must fit in d_out");
constexpr size_t R1_SEG_OFF = (size_t)MTOK * 3072 * 2, R1_SEGD_OFF = R1_SEG_OFF + (size_t)256 * 65536;
constexpr int HL_QI = 0, HL_KI = 17408, HL_QH = 60928, HL_KT = 78336, HL_IT = 96768, HL_PP = 115200, HL_REF = 124416, HL_TOT = 126976;
static_assert(HL_TOT + 2048 <= LDS_BYTES - 16, "hgrn local lds");
__device__ __forceinline__ void hgrn_local_items(const Args& a, LAS unsigned char* lds, int item) {
    const int first = item * 8, stride = 1, last = first + 8;
    const int tid = threadIdx.x, wid = tid >> 6, lane = tid & 63, fr = lane & 15, g = lane >> 4;
    const int d = tid & 127, rg = tid >> 7;
    const bf16_t* P = (const bf16_t*)(a.ws + WS_R1);
    LAS float* REF = (LAS float*)(lds + HL_REF); LAS float* TOT = (LAS float*)(lds + HL_TOT);
    bf16_t rq[16], rf[16], ri[16];
    f32x4 S[8];
#pragma unroll
    for (int n = 0; n < 8; ++n) S[n] = (f32x4){0.f, 0.f, 0.f, 0.f};
    float dtot[4] = {1.f, 1.f, 1.f, 1.f};
    { const int bh = first >> 5, ch = first & 31; const bf16_t* pr = P + (size_t)((bh >> 2) * SEQ + ch * 64 + 16 * rg) * 3072 + (bh & 3) * 128 + d;
#pragma unroll
        for (int t = 0; t < 16; ++t) { rq[t] = pr[(size_t)t * 3072]; rf[t] = pr[(size_t)t * 3072 + 512]; ri[t] = pr[(size_t)t * 3072 + 1024]; } }
    const float lbv = sigmoidf_(a.in[9][((first >> 5) & 3) * 128 + d] - a.in[9][512 + ((first >> 5) & 3) * 128 + d]);
    for (int idx = first; idx < last; idx += stride) {
        const int bh = idx >> 5, h = bh & 3;
        unsigned char* scr = (unsigned char*)a.out + (size_t)idx * HGS_STRIDE;
        float qv[16], kv[16], bb[16];
        { float run = 0.f; unsigned iv[8];
#pragma unroll
          for (int t = 0; t < 16; ++t) { const float fp = bf2f(rf[t]); qv[t] = bf2f(rq[t]);
              const float f = lbv + (1.0f - lbv) * sigmoidf_(fp); run += __logf(f); bb[t] = run; kv[t] = 1.0f - f;
              const unsigned iraw = ri[t]; if (t & 1) iv[t >> 1] |= iraw << 16; else iv[t >> 1] = iraw; }
          TOT[rg * 128 + d] = run;
          *(LAS u32x4*)(lds + HL_IT + d * 144 + rg * 32) = (u32x4){iv[0], iv[1], iv[2], iv[3]};
          *(LAS u32x4*)(lds + HL_IT + d * 144 + rg * 32 + 16) = (u32x4){iv[4], iv[5], iv[6], iv[7]}; }
        if (idx + stride < last) { const int nx = idx + stride, nbh = nx >> 5, nch = nx & 31; const bf16_t* pr = P + (size_t)((nbh >> 2) * SEQ + nch * 64 + 16 * rg) * 3072 + (nbh & 3) * 128 + d;
#pragma unroll
            for (int t = 0; t < 16; ++t) { rq[t] = pr[(size_t)t * 3072]; rf[t] = pr[(size_t)t * 3072 + 512]; ri[t] = pr[(size_t)t * 3072 + 1024]; } }
        wg_barrier();
        { float off = 0.f;
#pragma unroll
          for (int r = 0; r < 3; ++r) { const float tv = TOT[r * 128 + d]; off += (r < rg) ? tv : 0.f; }
#pragma unroll
          for (int t = 0; t < 16; ++t) bb[t] += off;
          REF[rg * 128 + d] = bb[8]; if (rg == 3) REF[512 + d] = bb[15]; }
        wg_barrier();
        { const float blast = REF[512 + d]; const float e1 = __expf(bb[8]), ft = __expf(blast - bb[8]);
          float fI[4];
#pragma unroll
          for (int I = 0; I < 4; ++I) fI[I] = __expf(fminf(REF[I * 128 + d] - bb[8], 0.f));
          unsigned kp[8]; float kt0 = 0.f;
#pragma unroll
          for (int t = 0; t < 16; ++t) { const int row = 16 * rg + t; const float eo = __expf(bb[t] - bb[8]); const float qi = qv[t] * eo, ki = kv[t] * __builtin_amdgcn_rcpf(eo);
              *(LAS bf16_t*)(lds + HL_QI + row * 272 + d * 2) = f2bf(qi);
              *(LAS bf16_t*)(lds + HL_QH + row * 272 + d * 2) = f2bf(qi * e1);
#pragma unroll
              for (int I = 0; I < 4; ++I) if (I >= rg) *(LAS bf16_t*)(lds + HL_KI + (8 * I * (I + 1) + row) * 272 + d * 2) = f2bf(ki * fI[I]);
              const float ktv = ki * ft; if (t & 1) kp[t >> 1] = pk2(kt0, ktv); else kt0 = ktv; }
          *(LAS u32x4*)(lds + HL_KT + d * 144 + rg * 32) = (u32x4){kp[0], kp[1], kp[2], kp[3]};
          *(LAS u32x4*)(lds + HL_KT + d * 144 + rg * 32 + 16) = (u32x4){kp[4], kp[5], kp[6], kp[7]}; }
        wg_barrier();
#pragma unroll
        for (int kk = 0; kk < 2; ++kk) { const int tile = wid + 8 * kk, I = tile >> 2, J = tile & 3;
            if (J <= I) { f32x4 c = (f32x4){0.f, 0.f, 0.f, 0.f};
#pragma unroll
                for (int ks = 0; ks < 4; ++ks) c = mfma16(lds_frag(lds, HL_QI + (16 * I + fr) * 272 + ks * 64 + g * 16), lds_frag(lds, HL_KI + (8 * I * (I + 1) + 16 * J + fr) * 272 + ks * 64 + g * 16), c);
#pragma unroll
                for (int j = 0; j < 4; ++j) { float v = c[j]; if (J == I && fr > 4 * g + j) v = 0.f; *(LAS bf16_t*)(lds + HL_PP + (16 * I + 4 * g + j) * 144 + (16 * J + fr) * 2) = f2bf(v); }
            } else {
#pragma unroll
                for (int j = 0; j < 4; ++j) *(LAS bf16_t*)(lds + HL_PP + (16 * I + 4 * g + j) * 144 + (16 * J + fr) * 2) = (bf16_t)0;
            } }
        wg_barrier();
        { float dec[4];
#pragma unroll
          for (int j = 0; j < 4; ++j) { dec[j] = __expf(REF[512 + 16 * wid + 4 * g + j]); dtot[j] *= dec[j]; }
#pragma unroll
          for (int n = 0; n < 8; ++n)
#pragma unroll
              for (int j = 0; j < 4; ++j) S[n][j] *= dec[j];
#pragma unroll
          for (int ks = 0; ks < 2; ++ks) { const bf16x8 av = lds_frag(lds, HL_KT + (16 * wid + fr) * 144 + ks * 64 + g * 16);
#pragma unroll
              for (int n = 0; n < 8; ++n) S[n] = mfma16(av, lds_frag(lds, HL_IT + (16 * n + fr) * 144 + ks * 64 + g * 16), S[n]); } }
#pragma unroll
        for (int k = 0; k < 2; ++k) { const int e = tid + 512 * k;
            *(u32x4*)(scr + HGS_QH + (size_t)e * 16) = *(const LAS u32x4*)(lds + HL_QH + (e >> 4) * 272 + (e & 15) * 16);
            *(u32x4*)(scr + HGS_KT + (size_t)e * 16) = *(const LAS u32x4*)(lds + HL_KT + (e >> 3) * 144 + (e & 7) * 16);
            *(u32x4*)(scr + HGS_IT + (size_t)e * 16) = *(const LAS u32x4*)(lds + HL_IT + (e >> 3) * 144 + (e & 7) * 16); }
        *(u32x4*)(scr + HGS_PP + (size_t)tid * 16) = *(const LAS u32x4*)(lds + HL_PP + (tid >> 3) * 144 + (tid & 7) * 16);
        if (tid < 128) ((float*)(scr + HGS_DEC))[tid] = __expf(REF[512 + tid]);
        wg_barrier();
    }
    { f32x4* so = (f32x4*)(a.ws + WS_R1 + R1_SEG_OFF + (size_t)item * 65536) + (size_t)wid * 512 + lane;
#pragma unroll
      for (int n = 0; n < 8; ++n) so[n * 64] = S[n];
      if (fr == 0) *(f32x4*)((float*)(a.ws + WS_R1 + R1_SEGD_OFF) + (size_t)item * 128 + 16 * wid + 4 * g) = (f32x4){dtot[0], dtot[1], dtot[2], dtot[3]}; }
}
constexpr size_t R1_SEG = (size_t)MTOK * 3072 * 2;
constexpr size_t R1_SEGD = R1_SEG + (size_t)256 * 65536;
static_assert(R1_SEGD + 256 * 512 <= R1_BYTES, "segment scratch");
__device__ __forceinline__ void hgrn_seg_state(const Args& a, LAS unsigned char* lds, int item) {
    const int tid = threadIdx.x, wid = tid >> 6, lane = tid & 63, fr = lane & 15, g = lane >> 4;
    const int bh = item >> 2, seg = item & 3;
    const unsigned char* scr0 = (const unsigned char*)a.out + ((size_t)bh * 32 + seg * 8) * HGS_STRIDE;
    LAS float* DEC = (LAS float*)(lds + HG_REF);
    f32x4 S[8];
#pragma unroll
    for (int n = 0; n < 8; ++n) S[n] = (f32x4){0.f, 0.f, 0.f, 0.f};
    float dtot[4] = {1.f, 1.f, 1.f, 1.f};
    u32x4 rk[2], ri[2]; float rd = 0.f;
#pragma unroll
    for (int k = 0; k < 2; ++k) { const unsigned e = tid + 512 * k; rk[k] = *(const u32x4*)(scr0 + HGS_KT + e * 16); ri[k] = *(const u32x4*)(scr0 + HGS_IT + e * 16); }
    if (tid < 128) rd = ((const float*)(scr0 + HGS_DEC))[tid];
    for (int c = 0; c < 8; ++c) {
#pragma unroll
        for (int k = 0; k < 2; ++k) { const int e = tid + 512 * k;
            *(LAS u32x4*)(lds + HG_KT + (e >> 3) * 144 + (e & 7) * 16) = rk[k];
            *(LAS u32x4*)(lds + HG_IT + (e >> 3) * 144 + (e & 7) * 16) = ri[k]; }
        if (tid < 128) DEC[tid] = rd;
        wg_barrier();
        if (c + 1 < 8) { const unsigned char* sc = scr0 + (size_t)(c + 1) * HGS_STRIDE;
#pragma unroll
            for (int k = 0; k < 2; ++k) { const unsigned e = tid + 512 * k; rk[k] = *(const u32x4*)(sc + HGS_KT + e * 16); ri[k] = *(const u32x4*)(sc + HGS_IT + e * 16); }
            if (tid < 128) rd = ((const float*)(sc + HGS_DEC))[tid]; }
        float dec[4];
#pragma unroll
        for (int j = 0; j < 4; ++j) { dec[j] = DEC[16 * wid + 4 * g + j]; dtot[j] *= dec[j]; }
#pragma unroll
        for (int n = 0; n < 8; ++n)
#pragma unroll
            for (int j = 0; j < 4; ++j) S[n][j] *= dec[j];
#pragma unroll
        for (int ks = 0; ks < 2; ++ks) { const bf16x8 av = lds_frag(lds, HG_KT + (16 * wid + fr) * 144 + ks * 64 + g * 16);
#pragma unroll
            for (int n = 0; n < 8; ++n) S[n] = mfma16(av, lds_frag(lds, HG_IT + (16 * n + fr) * 144 + ks * 64 + g * 16), S[n]); }
        wg_barrier();
    }
    f32x4* so = (f32x4*)(a.ws + WS_R1 + R1_SEG + (size_t)item * 65536) + (size_t)wid * 512 + lane;
#pragma unroll
    for (int n = 0; n < 8; ++n) so[n * 64] = S[n];
    if (fr == 0) *(f32x4*)((float*)(a.ws + WS_R1 + R1_SEGD) + (size_t)item * 128 + 16 * wid + 4 * g) = (f32x4){dtot[0], dtot[1], dtot[2], dtot[3]};
}
__device__ __forceinline__ void hgrn_seq_item(const Args& a, LAS unsigned char* lds, int item) {
    const int tid = threadIdx.x, wid = tid >> 6, lane = tid & 63, fr = lane & 15, g = lane >> 4;
    const int bh = item >> 2, seg = item & 3, ch_lo = seg * 8, ch_hi = ch_lo + 8;
    const int b = bh >> 2, h = bh & 3;
    const bf16_t* P = (const bf16_t*)(a.ws + WS_R1);
    bf16_t* cat = (bf16_t*)(a.ws + WS_CAT);
    const unsigned char* scr0 = (const unsigned char*)a.out + ((size_t)bh * 32 + ch_lo) * HGS_STRIDE;
    LAS float* DEC = (LAS float*)(lds + HG_REF); LAS float* SSQ = (LAS float*)(lds + HG_SS);
    f32x4 S[8];
#pragma unroll
    for (int n = 0; n < 8; ++n) S[n] = (f32x4){0.f, 0.f, 0.f, 0.f};
    for (int sp = 0; sp < seg; ++sp) {
        const f32x4* si = (const f32x4*)(a.ws + WS_R1 + R1_SEG + (size_t)(bh * 4 + sp) * 65536) + (size_t)wid * 512 + lane;
        const f32x4 dd = *(const f32x4*)((const float*)(a.ws + WS_R1 + R1_SEGD) + (size_t)(bh * 4 + sp) * 128 + 16 * wid + 4 * g);
#pragma unroll
        for (int n = 0; n < 8; ++n) S[n] = S[n] * dd + si[n * 64];
    }
#pragma unroll
    for (int n = 0; n < 8; ++n) { u32x2 w; w.x = pk2(S[n][0], S[n][1]); w.y = pk2(S[n][2], S[n][3]); *(LAS u32x2*)(lds + HG_ST + (16 * n + fr) * 272 + (16 * wid + 4 * g) * 2) = w; }
    const int tt_o = wid >> 1, dvh = wid & 1;
    float gn[4];
#pragma unroll
    for (int n = 0; n < 4; ++n) gn[n] = a.in[10][h * 128 + dvh * 64 + 16 * n + fr];
    u32x4 rq[2], rk[2], ri[2], rp; float rd = 0.f;
#pragma unroll
    for (int k = 0; k < 2; ++k) { const unsigned e = tid + 512 * k; rq[k] = *(const u32x4*)(scr0 + HGS_QH + e * 16); rk[k] = *(const u32x4*)(scr0 + HGS_KT + e * 16); ri[k] = *(const u32x4*)(scr0 + HGS_IT + e * 16); }
    rp = *(const u32x4*)(scr0 + HGS_PP + (unsigned)tid * 16); if (tid < 128) rd = ((const float*)(scr0 + HGS_DEC))[tid];
    f32x4 O[4];
#pragma unroll
    for (int n = 0; n < 4; ++n) O[n] = (f32x4){0.f, 0.f, 0.f, 0.f};
    bf16_t gq[4][4];
#pragma unroll
    for (int j = 0; j < 4; ++j)
#pragma unroll
        for (int n = 0; n < 4; ++n) gq[j][n] = 0;
    for (int ch = ch_lo; ch <= ch_hi; ++ch) {
        if (ch > ch_lo) {
            const int tok0 = b * SEQ + (ch - 1) * 64;
#pragma unroll
            for (int n = 0; n < 8; ++n) { u32x2 w; w.x = pk2(S[n][0], S[n][1]); w.y = pk2(S[n][2], S[n][3]); *(LAS u32x2*)(lds + HG_ST + (16 * n + fr) * 272 + (16 * wid + 4 * g) * 2) = w; }
#pragma unroll
            for (int j = 0; j < 4; ++j) { const int t = 16 * tt_o + 4 * g + j; const float rstd = rsqrtf((SSQ[t] + SSQ[64 + t]) * (1.0f / 128.0f) + EPS);
                const size_t tok = (size_t)(tok0 + t);
#pragma unroll
                for (int n = 0; n < 4; ++n) { const int dv = dvh * 64 + 16 * n + fr; const float gval = bf2f(gq[j][n]);
                    cat[tok * 1024 + h * 128 + dv] = f2bf(O[n][j] * rstd * gn[n] * siluf_(gval)); } }
        }
        if (ch == ch_hi) break;
#pragma unroll
        for (int k = 0; k < 2; ++k) { const int e = tid + 512 * k;
            *(LAS u32x4*)(lds + HG_QH + (e >> 4) * 272 + (e & 15) * 16) = rq[k];
            *(LAS u32x4*)(lds + HG_KT + (e >> 3) * 144 + (e & 7) * 16) = rk[k];
            *(LAS u32x4*)(lds + HG_IT + (e >> 3) * 144 + (e & 7) * 16) = ri[k]; }
        *(LAS u32x4*)(lds + HG_PP + (tid >> 3) * 144 + (tid & 7) * 16) = rp;
        if (tid < 128) DEC[tid] = rd;
        wg_barrier();
        if (ch + 1 < ch_hi) { const unsigned char* sc = scr0 + (size_t)(ch + 1 - ch_lo) * HGS_STRIDE;
#pragma unroll
            for (int k = 0; k < 2; ++k) { const unsigned e = tid + 512 * k; rq[k] = *(const u32x4*)(sc + HGS_QH + e * 16); rk[k] = *(const u32x4*)(sc + HGS_KT + e * 16); ri[k] = *(const u32x4*)(sc + HGS_IT + e * 16); }
            rp = *(const u32x4*)(sc + HGS_PP + (unsigned)tid * 16); if (tid < 128) rd = ((const float*)(sc + HGS_DEC))[tid]; }
        { const bf16_t* gp = P + (size_t)(b * SEQ + ch * 64 + 16 * tt_o + 4 * g) * 3072 + 1536 + h * 128 + dvh * 64 + fr;
#pragma unroll
          for (int j = 0; j < 4; ++j)
#pragma unroll
              for (int n = 0; n < 4; ++n) gq[j][n] = gp[(size_t)j * 3072 + 16 * n]; }
#pragma unroll
        for (int n = 0; n < 4; ++n) O[n] = (f32x4){0.f, 0.f, 0.f, 0.f};
#pragma unroll
        for (int ks = 0; ks < 4; ++ks) { const bf16x8 av = lds_frag(lds, HG_QH + (16 * tt_o + fr) * 272 + ks * 64 + g * 16);
#pragma unroll
            for (int n = 0; n < 4; ++n) O[n] = mfma16(av, lds_frag(lds, HG_ST + (dvh * 64 + 16 * n + fr) * 272 + ks * 64 + g * 16), O[n]); }
        for (int ks = 0; ks <= (tt_o >> 1); ++ks) { const bf16x8 av = lds_frag(lds, HG_PP + (16 * tt_o + fr) * 144 + ks * 64 + g * 16);
#pragma unroll
            for (int n = 0; n < 4; ++n) O[n] = mfma16(av, lds_frag(lds, HG_IT + (dvh * 64 + 16 * n + fr) * 144 + ks * 64 + g * 16), O[n]); }
#pragma unroll
        for (int j = 0; j < 4; ++j) { float s = O[0][j] * O[0][j] + O[1][j] * O[1][j] + O[2][j] * O[2][j] + O[3][j] * O[3][j];
            s += __shfl_xor(s, 1); s += __shfl_xor(s, 2); s += __shfl_xor(s, 4); s += __shfl_xor(s, 8);
            if (fr == 0) SSQ[dvh * 64 + 16 * tt_o + 4 * g + j] = s; }
        { float dec[4];
#pragma unroll
          for (int j = 0; j < 4; ++j) dec[j] = DEC[16 * wid + 4 * g + j];
#pragma unroll
          for (int n = 0; n < 8; ++n)
#pragma unroll
              for (int j = 0; j < 4; ++j) S[n][j] *= dec[j];
#pragma unroll
          for (int ks = 0; ks < 2; ++ks) { const bf16x8 av = lds_frag(lds, HG_KT + (16 * wid + fr) * 144 + ks * 64 + g * 16);
#pragma unroll
              for (int n = 0; n < 8; ++n) S[n] = mfma16(av, lds_frag(lds, HG_IT + (16 * n + fr) * 144 + ks * 64 + g * 16), S[n]); } }
        wg_barrier();
    }
    wg_barrier();
}

constexpr int SG_W = 0, SG_V = 34816;
typedef short v4i16_t __attribute__((ext_vector_type(4)));
__device__ __forceinline__ void sgu_items(const Args& a, LAS unsigned char* lds, int first, int stride) {
    const int tid = threadIdx.x, wid = tid >> 6, lane = tid & 63, fr = lane & 15, g = lane >> 4;
    const int gi = first & 3;
    const bf16_t* P = (const bf16_t*)(a.ws + WS_R1);
    bf16_t* cat = (bf16_t*)(a.ws + WS_CAT);
    { const float* W = a.in[13] + (size_t)gi * 16384;
#pragma unroll
      for (int k = 0; k < 4; ++k) { const int e = tid + 512 * k, t = e >> 4, s0 = (e & 15) * 8; const f32x4 w0 = *(const f32x4*)(W + t * 128 + s0), w1 = *(const f32x4*)(W + t * 128 + s0 + 4);
          float v[8] = {w0[0], w0[1], w0[2], w0[3], w1[0], w1[1], w1[2], w1[3]};
#pragma unroll
          for (int j = 0; j < 8; ++j) if (s0 + j > t) v[j] = 0.f;
          *(LAS u32x4*)(lds + SG_W + t * 272 + s0 * 2) = (u32x4){pk2(v[0], v[1]), pk2(v[2], v[3]), pk2(v[4], v[5]), pk2(v[6], v[7])}; } }
    const int cg = tid & 15, srow = tid >> 4;
    float lgv[8], lbv[8];
#pragma unroll
    for (int j = 0; j < 8; ++j) { lgv[j] = a.in[11][gi * 128 + 8 * cg + j]; lbv[j] = a.in[12][gi * 128 + 8 * cg + j]; }
    const int q = fr >> 2, pp = fr & 3;
    const float bs = a.in[14][gi * 128 + 16 * wid + fr];
    u32x4 rv[4];
    if (first < 1024) {
#pragma unroll
        for (int k = 0; k < 4; ++k) rv[k] = *(const u32x4*)(P + (size_t)((first >> 2) * 128 + srow + 32 * k) * 3072 + 2560 + gi * 128 + 8 * cg); }
    for (int it = first; it < 1024; it += stride) {
        const int tok0 = (it >> 2) * 128;
#pragma unroll
        for (int k = 0; k < 4; ++k) { float x[8] = {bflo(rv[k].x), bfhi(rv[k].x), bflo(rv[k].y), bfhi(rv[k].y), bflo(rv[k].z), bfhi(rv[k].z), bflo(rv[k].w), bfhi(rv[k].w)};
            float s1 = 0.f, s2 = 0.f;
#pragma unroll
            for (int j = 0; j < 8; ++j) { s1 += x[j]; s2 += x[j] * x[j]; }
#pragma unroll
            for (int off = 1; off < 16; off <<= 1) { s1 += __shfl_xor(s1, off); s2 += __shfl_xor(s2, off); }
            const float mean = s1 * (1.0f / 128.0f), rstd = rsqrtf(fmaxf(s2 * (1.0f / 128.0f) - mean * mean, 0.f) + EPS);
#pragma unroll
            for (int j = 0; j < 8; ++j) x[j] = (x[j] - mean) * rstd * lgv[j] + lbv[j];
            *(LAS u32x4*)(lds + SG_V + (srow + 32 * k) * 272 + cg * 16) = (u32x4){pk2(x[0], x[1]), pk2(x[2], x[3]), pk2(x[4], x[5]), pk2(x[6], x[7])}; }
        wg_barrier();
        if (it + stride < 1024) {
#pragma unroll
            for (int k = 0; k < 4; ++k) rv[k] = *(const u32x4*)(P + (size_t)(((it + stride) >> 2) * 128 + srow + 32 * k) * 3072 + 2560 + gi * 128 + 8 * cg); }
        u32x2 uu[8];
        { const bf16_t* up = P + (size_t)(tok0 + 16 * wid + fr) * 3072 + 2048 + gi * 128 + 4 * g;
#pragma unroll
          for (int m = 0; m < 8; ++m) uu[m] = *(const u32x2*)(up + 16 * m); }
        f32x4 Z[8];
#pragma unroll
        for (int m = 0; m < 8; ++m) Z[m] = (f32x4){0.f, 0.f, 0.f, 0.f};
        for (int ks = 0; ks <= (wid >> 1); ++ks) { const bf16x8 bw = lds_frag(lds, SG_W + (16 * wid + fr) * 272 + ks * 64 + g * 16);
#pragma unroll
            for (int m = 0; m < 8; ++m) { LAS unsigned char* ap = lds + SG_V + (32 * ks + 8 * g + q) * 272 + (16 * m + 4 * pp) * 2;
                const v4i16_t a0 = __builtin_amdgcn_ds_read_tr16_b64_v4i16((LAS v4i16_t*)ap), a1 = __builtin_amdgcn_ds_read_tr16_b64_v4i16((LAS v4i16_t*)(ap + 4 * 272));
                const bf16x8 av = (bf16x8){a0[0], a0[1], a0[2], a0[3], a1[0], a1[1], a1[2], a1[3]};
                Z[m] = mfma16(av, bw, Z[m]); } }
        { const int t = 16 * wid + fr; const size_t tok = (size_t)(tok0 + t);
          bf16_t* op = cat + tok * 1024 + 512 + gi * 128 + 4 * g;
#pragma unroll
          for (int m = 0; m < 8; ++m) { u32x2 w; w.x = pk2(bflo(uu[m].x) * (Z[m][0] + bs), bfhi(uu[m].x) * (Z[m][1] + bs)); w.y = pk2(bflo(uu[m].y) * (Z[m][2] + bs), bfhi(uu[m].y) * (Z[m][3] + bs)); *(u32x2*)(op + 16 * m) = w; } }
        wg_barrier();
    }
}

__device__ __forceinline__ void conv_items(const Args& a, LAS unsigned char* lds) {
    const int tid = threadIdx.x, wid = tid >> 6, lane = tid & 63, c = tid;
    const bf16_t* H = (const bf16_t*)(a.ws + WS_R1 + R1_HGLU);
    bf16_t* cat = (bf16_t*)(a.ws + WS_CAT);
    LAS float* YS = (LAS float*)lds; LAS float* ST2 = (LAS float*)(lds + 32768);
    float w[31];
#pragma unroll
    for (int j = 0; j < 31; ++j) w[j] = a.in[17][j * 512 + c];
    const float cb = a.in[18][c], lg = a.in[19][c], lb = a.in[20][c];
#define CONV_ITEM(i) ((gridDim.x == 256) ? (((i) & 7) * 256 + ((i) >> 3)) : (i))
    bf16_t xr[46];
    if ((int)blockIdx.x < MTOK / 16) { const int tok0 = CONV_ITEM((int)blockIdx.x) * 16, t0 = tok0 & 2047;
#pragma unroll
        for (int i = 0; i < 46; ++i) { const int t = t0 - 30 + i; xr[i] = H[(size_t)(tok0 + (t >= 0 ? i - 30 : 0)) * 512 + c]; } }
    for (int item = blockIdx.x; item < MTOK / 16; item += gridDim.x) {
        const int tok0 = CONV_ITEM(item) * 16, t0 = tok0 & 2047;
        float x[46];
#pragma unroll
        for (int i = 0; i < 46; ++i) { const int t = t0 - 30 + i; x[i] = (t >= 0) ? bf2f(xr[i]) : 0.f; }
        if (item + (int)gridDim.x < MTOK / 16) { const int ntok0 = CONV_ITEM(item + (int)gridDim.x) * 16, nt0 = ntok0 & 2047;
#pragma unroll
            for (int i = 0; i < 46; ++i) { const int t = nt0 - 30 + i; xr[i] = H[(size_t)(ntok0 + (t >= 0 ? i - 30 : 0)) * 512 + c]; } }
        float y[16];
#pragma unroll
        for (int o = 0; o < 16; ++o) { float s = cb;
#pragma unroll
            for (int j = 0; j < 31; ++j) s += w[j] * x[o + j];
            y[o] = s; YS[o * 512 + c] = s; }
        wg_barrier();
#pragma unroll
        for (int k = 0; k < 2; ++k) { const int o = 2 * wid + k; float v[8]; float sm = 0.f;
#pragma unroll
            for (int i = 0; i < 8; ++i) { v[i] = YS[o * 512 + lane + 64 * i]; sm += v[i]; }
#pragma unroll
            for (int off = 1; off < 64; off <<= 1) sm += __shfl_xor(sm, off);
            const float mean = sm * (1.0f / 512.0f); float q = 0.f;
#pragma unroll
            for (int i = 0; i < 8; ++i) q += (v[i] - mean) * (v[i] - mean);
#pragma unroll
            for (int off = 1; off < 64; off <<= 1) q += __shfl_xor(q, off);
            if (lane == 0) { ST2[2 * o] = mean; ST2[2 * o + 1] = rsqrtf(q * (1.0f / 512.0f) + EPS); } }
        wg_barrier();
#pragma unroll
        for (int o = 0; o < 16; ++o) { const float v = (y[o] - ST2[2 * o]) * ST2[2 * o + 1] * lg + lb; cat[(size_t)(tok0 + o) * 1024 + c] = f2bf(siluf_(v)); }
        wg_barrier();
    }
}
__device__ __forceinline__ void krope_items(const Args& a) {
    const bf16_t* pq = (const bf16_t*)(a.ws + WS_R1 + R1_PQKV); bf16_t* Kb = (bf16_t*)(a.ws + WS_R1 + R1_KB); const float* rope = (const float*)(a.ws + WS_ROPE);
    for (int i = blockIdx.x * 512 + threadIdx.x; i < MTOK * 4; i += gridDim.x * 512) { const int tok = i >> 2, k8 = (i & 3) * 8;
        const u32x4 r1 = *(const u32x4*)(pq + (size_t)tok * 768 + 640 + k8), r2 = *(const u32x4*)(pq + (size_t)tok * 768 + 672 + k8);
        const float* rp = rope + (size_t)tok * 64 + k8; const f32x4 c0 = *(const f32x4*)rp, c1 = *(const f32x4*)(rp + 4), s0 = *(const f32x4*)(rp + 32), s1 = *(const f32x4*)(rp + 36);
        const float x1[8] = {bflo(r1.x), bfhi(r1.x), bflo(r1.y), bfhi(r1.y), bflo(r1.z), bfhi(r1.z), bflo(r1.w), bfhi(r1.w)}, x2[8] = {bflo(r2.x), bfhi(r2.x), bflo(r2.y), bfhi(r2.y), bflo(r2.z), bfhi(r2.z), bflo(r2.w), bfhi(r2.w)};
        const float cs[8] = {c0[0], c0[1], c0[2], c0[3], c1[0], c1[1], c1[2], c1[3]}, sn[8] = {s0[0], s0[1], s0[2], s0[3], s1[0], s1[1], s1[2], s1[3]};
        float o1[8], o2[8];
#pragma unroll
        for (int j = 0; j < 8; ++j) { o1[j] = x1[j] * cs[j] - x2[j] * sn[j]; o2[j] = x1[j] * sn[j] + x2[j] * cs[j]; }
        const u32x4 w1 = (u32x4){pk2(o1[0], o1[1]), pk2(o1[2], o1[3]), pk2(o1[4], o1[5]), pk2(o1[6], o1[7])}, w2 = (u32x4){pk2(o2[0], o2[1]), pk2(o2[2], o2[3]), pk2(o2[4], o2[5]), pk2(o2[6], o2[7])};
        const int b = tok >> 11, t = tok & 2047;
#pragma unroll
        for (int h = 0; h < 4; ++h) { bf16_t* kr = Kb + ((size_t)(b * 4 + h) * 2048 + t) * 192 + 128 + k8; *(u32x4*)kr = w1; *(u32x4*)(kr + 32) = w2; } }
}

constexpr int AT_K = 0, AT_V = 67584, AT_KB = 33792, AT_VB = 18432;
__device__ __forceinline__ void attn_items(const Args& a, LAS unsigned char* lds) {
    const int tid = threadIdx.x, wid = __builtin_amdgcn_readfirstlane(tid >> 6), lane = tid & 63, fr = lane & 15, g = lane >> 4;
    const bf16_t* Q = (const bf16_t*)(a.ws + WS_R1 + R1_Q); const bf16_t* Kb = (const bf16_t*)(a.ws + WS_R1 + R1_KB); const bf16_t* Vt = (const bf16_t*)(a.ws + WS_R1 + R1_VT);
    const float* rope = (const float*)(a.ws + WS_ROPE); bf16_t* cat = (bf16_t*)(a.ws + WS_CAT);
    for (int item0 = blockIdx.x; item0 < 256; item0 += gridDim.x) {
        const int item = (gridDim.x == 256) ? ((item0 & 7) * 32 + (item0 >> 3)) : item0;
        const int bh = item >> 2, p = item & 3, b = bh >> 2, h = bh & 3;
        const unsigned char* kbase = (const unsigned char*)(Kb + (size_t)bh * 2048 * 192);
        const unsigned char* vbase = (const unsigned char*)(Vt + (size_t)bh * 2048 * 128);
        for (int half = 0; half < 2; ++half) {
            const int qb = half ? 7 - p : p;
            const int q0 = qb * 256 + wid * 32;
            bf16x8 qf[2][6];
#pragma unroll
            for (int qt = 0; qt < 2; ++qt) { const size_t tok = (size_t)b * SEQ + q0 + 16 * qt + fr; const bf16_t* qr = Q + tok * 768 + h * 192 + 8 * g;
#pragma unroll
                for (int ks = 0; ks < 6; ++ks) qf[qt][ks] = *(const bf16x8*)(qr + 32 * ks);
                const float* rp = rope + tok * 64 + 8 * g; const f32x4 c0 = *(const f32x4*)rp, c1 = *(const f32x4*)(rp + 4), s0 = *(const f32x4*)(rp + 32), s1 = *(const f32x4*)(rp + 36);
                const float cs[8] = {c0[0], c0[1], c0[2], c0[3], c1[0], c1[1], c1[2], c1[3]}, sn[8] = {s0[0], s0[1], s0[2], s0[3], s1[0], s1[1], s1[2], s1[3]};
                bf16x8 r1, r2;
#pragma unroll
                for (int j = 0; j < 8; ++j) { const float x1 = bf2f((bf16_t)qf[qt][4][j]), x2 = bf2f((bf16_t)qf[qt][5][j]);
                    r1[j] = (short)f2bf(x1 * cs[j] - x2 * sn[j]); r2[j] = (short)f2bf(x1 * sn[j] + x2 * cs[j]); }
                qf[qt][4] = r1; qf[qt][5] = r2; }
            f32x4 O[8][2];
#pragma unroll
            for (int mt = 0; mt < 8; ++mt) { O[mt][0] = (f32x4){0.f, 0.f, 0.f, 0.f}; O[mt][1] = (f32x4){0.f, 0.f, 0.f, 0.f}; }
            float mrow[2] = {-1e30f, -1e30f}, lrow[2] = {0.f, 0.f};
            const int ntile = qb * 4 + 4;
            u32x4 kreg[3], vreg[2];
#pragma unroll
            for (int k = 0; k < 3; ++k) kreg[k] = *(const u32x4*)(kbase + (unsigned)(tid * 16 + 8192 * k));
#pragma unroll
            for (int k = 0; k < 2; ++k) { const int e = tid + 512 * k; vreg[k] = *(const u32x4*)(vbase + (unsigned)(e * 16)); }
#pragma unroll
            for (int k = 0; k < 3; ++k) { const int e = tid + 512 * k; const int r_ = e / 24, c_ = e % 24; *(LAS u32x4*)(lds + AT_K + r_ * 528 + ((c_ ^ (((r_ + 4) >> 3) & 1)) * 16)) = kreg[k]; }
#pragma unroll
            for (int k = 0; k < 2; ++k) { const int e = tid + 512 * k; *(LAS u32x4*)(lds + AT_V + (e >> 4) * 288 + (e & 15) * 16) = vreg[k]; }
            wg_barrier();
            for (int kt = 0; kt < ntile; ++kt) {
                const int buf = kt & 1; const bool more = kt + 1 < ntile;
                LAS unsigned char* ks_ = lds + AT_K + buf * AT_KB; LAS unsigned char* vs_ = lds + AT_V + buf * AT_VB; const int gx = (g ^ (((fr + 4) >> 3) & 1)) * 16;
                if (more) {
#pragma unroll
                    for (int k = 0; k < 3; ++k) kreg[k] = *(const u32x4*)(kbase + (size_t)(kt + 1) * 24576 + (unsigned)(tid * 16 + 8192 * k));
#pragma unroll
                    for (int k = 0; k < 2; ++k) { const int e = tid + 512 * k; vreg[k] = *(const u32x4*)(vbase + (size_t)(kt + 1) * 16384 + (unsigned)(e * 16)); }
                }
#pragma unroll
                for (int u = 0; u < 2; ++u) {
                    if (kt * 64 + 32 * u <= q0) {
                        f32x4 st[2][2];
#pragma unroll
                        for (int kk = 0; kk < 2; ++kk) { st[kk][0] = (f32x4){0.f, 0.f, 0.f, 0.f}; st[kk][1] = (f32x4){0.f, 0.f, 0.f, 0.f};
#pragma unroll
                            for (int ks = 0; ks < 6; ++ks) { const bf16x8 kf = lds_frag(ks_, (16 * (2 * u + kk) + fr) * 528 + ks * 64 + gx);
                                st[kk][0] = mfma16(kf, qf[0][ks], st[kk][0]); st[kk][1] = mfma16(kf, qf[1][ks], st[kk][1]); } }
                        if (kt * 64 + 32 * u == q0) {
#pragma unroll
                            for (int kk = 0; kk < 2; ++kk)
#pragma unroll
                                for (int qt = 0; qt < 2; ++qt)
#pragma unroll
                                    for (int j = 0; j < 4; ++j) if (16 * kk + 4 * g + j > 16 * qt + fr) st[kk][qt][j] = -INFINITY;
                        }
                        bf16x8 pb[2];
#pragma unroll
                        for (int qt = 0; qt < 2; ++qt) { float mx = -INFINITY;
#pragma unroll
                            for (int kk = 0; kk < 2; ++kk)
#pragma unroll
                                for (int j = 0; j < 4; ++j) mx = fmaxf(mx, st[kk][qt][j]);
                            mx = xor16_max(mx); mx = xor32_max(mx);
                            const bool need = mx > mrow[qt] + 8.0f;
                            if (__builtin_amdgcn_ballot_w64(need) != 0ull) { const float mnew = need ? mx : mrow[qt], alpha = __builtin_amdgcn_exp2f(mrow[qt] - mnew); mrow[qt] = mnew; lrow[qt] *= alpha;
#pragma unroll
                                for (int mt = 0; mt < 8; ++mt) O[mt][qt] *= alpha; }
                            const float mref = mrow[qt]; float ls = 0.f;
#pragma unroll
                            for (int kk = 0; kk < 2; ++kk)
#pragma unroll
                                for (int j = 0; j < 4; ++j) { const float pv = __builtin_amdgcn_exp2f(st[kk][qt][j] - mref); st[kk][qt][j] = pv; ls += pv; }
                            lrow[qt] += ls;
                            pb[qt] = __builtin_bit_cast(bf16x8, (u32x4){pk2(st[0][qt][0], st[0][qt][1]), pk2(st[0][qt][2], st[0][qt][3]), pk2(st[1][qt][0], st[1][qt][1]), pk2(st[1][qt][2], st[1][qt][3])}); }
#pragma unroll
                        for (int mt = 0; mt < 8; ++mt) { LAS unsigned char* vp_ = vs_ + (32 * u + 4 * g + (fr >> 2)) * 288 + (16 * mt + 4 * (fr & 3)) * 2;
                            const v4i16_t a0 = __builtin_amdgcn_ds_read_tr16_b64_v4i16((LAS v4i16_t*)vp_), a1 = __builtin_amdgcn_ds_read_tr16_b64_v4i16((LAS v4i16_t*)(vp_ + 16 * 288));
                            const bf16x8 vf = (bf16x8){a0[0], a0[1], a0[2], a0[3], a1[0], a1[1], a1[2], a1[3]};
                            O[mt][0] = mfma16(vf, pb[0], O[mt][0]); O[mt][1] = mfma16(vf, pb[1], O[mt][1]); }
                    }
                    if (more) {
                        if (u == 0) {
#pragma unroll
                            for (int k = 0; k < 3; ++k) { const int e = tid + 512 * k; const int r_ = e / 24, c_ = e % 24; *(LAS u32x4*)(lds + AT_K + (buf ^ 1) * AT_KB + r_ * 528 + ((c_ ^ (((r_ + 4) >> 3) & 1)) * 16)) = kreg[k]; }
                        } else {
#pragma unroll
                            for (int k = 0; k < 2; ++k) { const int e = tid + 512 * k; *(LAS u32x4*)(lds + AT_V + (buf ^ 1) * AT_VB + (e >> 4) * 288 + (e & 15) * 16) = vreg[k]; }
                        }
                    }
                }
                wg_barrier();
            }
#pragma unroll
            for (int qt = 0; qt < 2; ++qt) { float l = lrow[qt]; l += __shfl_xor(l, 16); l += __shfl_xor(l, 32); const float inv = 1.0f / l;
                bf16_t* orow = cat + ((size_t)b * SEQ + q0 + 16 * qt + fr) * 1024 + 512 + h * 128 + 4 * g;
#pragma unroll
                for (int mt = 0; mt < 8; ++mt) { u32x2 w; w.x = pk2(O[mt][qt][0] * inv, O[mt][qt][1] * inv); w.y = pk2(O[mt][qt][2] * inv, O[mt][qt][3] * inv); *(u32x2*)(orow + 16 * mt) = w; } }
        }
    }
}

__device__ __forceinline__ void final_norm(const Args& a) {
    const float* ss4 = (const float*)(a.ws + WS_SS) + 4 * MTOK; const bf16_t* xb = (const bf16_t*)(a.ws + WS_XB);
    const int stride = gridDim.x * 512;
    for (int i0 = blockIdx.x * 512 + threadIdx.x; i0 < MTOK * 128; i0 += 4 * stride) {
        u32x4 r[4]; float sq[4];
#pragma unroll
        for (int k = 0; k < 4; ++k) { const int i = (i0 + k * stride < MTOK * 128) ? i0 + k * stride : i0; r[k] = *(const u32x4*)(xb + (size_t)(i >> 7) * 1024 + (i & 127) * 8); sq[k] = ss4[i >> 7]; }
#pragma unroll
        for (int k = 0; k < 4; ++k) { const int i = i0 + k * stride; if (i < MTOK * 128) { const int row = i >> 7, c8 = (i & 127) * 8;
            const float rstd = rsqrtf(sq[k] * (1.0f / 1024.0f) + EPS);
            const f32x4 w0 = *(const f32x4*)(a.in[25] + c8), w1 = *(const f32x4*)(a.in[25] + c8 + 4);
            f32x4 o0 = (f32x4){bflo(r[k].x), bfhi(r[k].x), bflo(r[k].y), bfhi(r[k].y)}, o1 = (f32x4){bflo(r[k].z), bfhi(r[k].z), bflo(r[k].w), bfhi(r[k].w)};
            o0 = o0 * rstd * w0; o1 = o1 * rstd * w1;
            __builtin_nontemporal_store(o0, (f32x4*)(a.out + (size_t)row * 1024 + c8)); __builtin_nontemporal_store(o1, (f32x4*)(a.out + (size_t)row * 1024 + c8 + 4)); } }
    }
}

constexpr int NPHASE = 13;
__global__ void __launch_bounds__(512, 2) mega(Args a) {
    extern __shared__ __attribute__((aligned(16))) unsigned char shm[];
    LAS unsigned char* lds = (LAS unsigned char*)shm;
    cg::grid_group grid = cg::this_grid();
    volatile LAS unsigned* xst = (volatile LAS unsigned*)(lds + LDS_BYTES - 16);
    if (threadIdx.x == 0) { xst[0] = 0u; xst[1] = 0u; }
    __syncthreads();
    const XcdBarrier xbar = xcd_barrier_post((unsigned*)(a.ws + WS_BAR), xst);
    unsigned char* ws = a.ws;
    float* ss = (float*)(ws + WS_SS);
    bf16_t* xb = (bf16_t*)(ws + WS_XB); bf16_t* cat = (bf16_t*)(ws + WS_CAT); bf16_t* r1 = (bf16_t*)(ws + WS_R1);
#define PHASE_BEGIN(n) if (a.ph_lo <= (n) && (n) < a.ph_hi) {
#define PHASE_END(n) if ((n) + 1 < a.ph_hi) { xcd_barrier(xbar); } }
#ifndef REP_MASK
#define REP_MASK 0
#endif
#define REP_EN(n) (((REP_MASK) >> (n)) & 1)
    if (a.ph_hi > 1000) grid.sync();
    PHASE_BEGIN(0) phase_prologue(a, lds); if (REP_EN(0)) { xcd_barrier(xbar); phase_prologue(a, lds); } PHASE_END(0)
    PHASE_BEGIN(1) { EpiInEven E; E.O = r1; E.ss = ss; E.ssrc = ss; run_gemm(lds, xb, 1024, (const bf16_t*)(ws + WS_W_IN0), 3072, 1024, E); if (REP_EN(1)) { xcd_barrier(xbar); run_gemm(lds, xb, 1024, (const bf16_t*)(ws + WS_W_IN0), 3072, 1024, E); } } PHASE_END(1)
    PHASE_BEGIN(2) { const int G = gridDim.x, bx = blockIdx.x;
                  for (int it = bx; it < 256; it += G) hgrn_local_items(a, lds, it);
                  if (bx < (G & ~3)) sgu_items(a, lds, bx, G & ~3);
                  xcd_barrier(xbar);
                  for (int it = bx; it < 256; it += G) hgrn_seq_item(a, lds, it);
                  if (REP_EN(2)) { xcd_barrier(xbar); for (int it = bx; it < 256; it += G) hgrn_local_items(a, lds, it); }
                  if (REP_EN(14)) { xcd_barrier(xbar); for (int it = bx; it < 256; it += G) if ((it & 3) != 3) hgrn_seg_state(a, lds, it); if (bx < (G & ~3)) sgu_items(a, lds, bx, G & ~3); }
                  if (REP_EN(13)) { xcd_barrier(xbar); for (int it = bx; it < 256; it += G) hgrn_seq_item(a, lds, it); } } PHASE_END(2)
    PHASE_BEGIN(3) { EpiResid E; E.xb = xb; E.ss = ss + MTOK; run_gemm(lds, cat, 1024, (const bf16_t*)(ws + WS_W_OUT0), 1024, 1024, E); } PHASE_END(3)
    PHASE_BEGIN(4) { EpiSwiglu E; E.O = r1; E.ss = ss + MTOK; E.ssrc = ss + MTOK; run_gemm(lds, xb, 1024, (const bf16_t*)(ws + WS_W_GU0), 5632, 1024, E); if (REP_EN(4)) { xcd_barrier(xbar); run_gemm(lds, xb, 1024, (const bf16_t*)(ws + WS_W_GU0), 5632, 1024, E); } } PHASE_END(4)
    if (REP_MASK & 0xe0000) { if (a.ph_lo <= 4 && 4 < a.ph_hi) { EpiNull E; E.sink = (float*)(ws + WS_BAR + 8192);
        if (REP_EN(17)) run_gemm(lds, xb, 1024, (const bf16_t*)(ws + WS_W_IN0), 3072, 1024, E);
        if (REP_EN(18)) run_gemm(lds, r1, FF, (const bf16_t*)(ws + WS_W_D0), 1024, FF, E);
        if (REP_EN(19)) run_gemm(lds, cat, 1024, (const bf16_t*)(ws + WS_W_OUT0), 1024, 1024, E);
        xcd_barrier(xbar); } }
    PHASE_BEGIN(5) { EpiResid E; E.xb = xb; E.ss = ss + 2 * MTOK; run_gemm(lds, r1, FF, (const bf16_t*)(ws + WS_W_D0), 1024, FF, E); } PHASE_END(5)
    PHASE_BEGIN(6) { EpiInOdd E; E.hglu = (bf16_t*)(ws + WS_R1 + R1_HGLU); E.pqkv = (bf16_t*)(ws + WS_R1 + R1_PQKV); E.ss = ss + 2 * MTOK; E.ssrc = ss + 2 * MTOK; E.ssq = ss + 5 * MTOK; E.sskv = ss + 6 * MTOK;
                  E.thr = 3; E.off0 = 0; E.off1 = 1;
                  run_gemm(lds, xb, 1024, (const bf16_t*)(ws + WS_W_IN1), 1536, 1024, E); } PHASE_END(6)
    PHASE_BEGIN(7) { const int G = gridDim.x, bx = blockIdx.x;
                  { EpiInOdd E; E.hglu = (bf16_t*)(ws + WS_R1 + R1_HGLU); E.pqkv = (bf16_t*)(ws + WS_R1 + R1_PQKV); E.ss = ss + 2 * MTOK; E.ssrc = ss + 2 * MTOK; E.ssq = ss + 5 * MTOK; E.sskv = ss + 6 * MTOK;
                    E.thr = 1; E.off0 = 3; E.off1 = 3;
                    run_gemm(lds, xb, 1024, (const bf16_t*)(ws + WS_W_IN1) + (size_t)1536 * 1024, 256, 1024, E); }
                  { EpiUq E; E.Q = (bf16_t*)(ws + WS_R1 + R1_Q); E.ssq = ss + 5 * MTOK; E.ssrc = ss + 5 * MTOK;
                    if (G == 256) { ListOrder S; S.nM = 128; S.nN = 3; if (bx < 128) { S.first = bx; S.cnt = 1; } else { S.first = 128 + (bx - 128) * 2; S.cnt = 2; }
                        run_gemm_s(lds, (const bf16_t*)(ws + WS_R1 + R1_PQKV), 768, (const bf16_t*)(ws + WS_W_UQ), 768, 384, E, S); }
                    else run_gemm(lds, (const bf16_t*)(ws + WS_R1 + R1_PQKV), 768, (const bf16_t*)(ws + WS_W_UQ), 768, 384, E); }
                  { EpiUkv E; E.Kb = (bf16_t*)(ws + WS_R1 + R1_KB); E.Vt = (bf16_t*)(ws + WS_R1 + R1_VT); E.sskv = ss + 6 * MTOK; E.ssrc = ss + 6 * MTOK;
                    if (G == 256) { ListOrder S; S.nM = 128; S.nN = 4; if (bx < 128) { S.first = bx; S.cnt = 1; } else { S.first = 128 + (bx - 128) * 3; S.cnt = 3; }
                        run_gemm_s(lds, (const bf16_t*)(ws + WS_R1 + R1_PQKV) + 384, 768, (const bf16_t*)(ws + WS_W_UKV), 1024, 256, E, S); }
                    else run_gemm(lds, (const bf16_t*)(ws + WS_R1 + R1_PQKV) + 384, 768, (const bf16_t*)(ws + WS_W_UKV), 1024, 256, E); }
                  krope_items(a); } PHASE_END(7)
    PHASE_BEGIN(8) attn_items(a, lds); conv_items(a, lds); PHASE_END(8)
    PHASE_BEGIN(9) { EpiResid E; E.xb = xb; E.ss = ss + 3 * MTOK; run_gemm(lds, cat, 1024, (const bf16_t*)(ws + WS_W_OUT1), 1024, 1024, E); } PHASE_END(9)
    PHASE_BEGIN(10) { EpiSwiglu E; E.O = r1; E.ss = ss + 3 * MTOK; E.ssrc = ss + 3 * MTOK; run_gemm(lds, xb, 1024, (const bf16_t*)(ws + WS_W_GU1), 5632, 1024, E); } PHASE_END(10)
    PHASE_BEGIN(11) { EpiResid E; E.xb = xb; E.ss = ss + 4 * MTOK; run_gemm(lds, r1, FF, (const bf16_t*)(ws + WS_W_D1), 1024, FF, E); } PHASE_END(11)
    PHASE_BEGIN(12) final_norm(a); PHASE_END(12)
}

#ifndef MK_ONE_LAUNCH
#define MK_ONE_LAUNCH 1
#endif
extern "C" void kernel_launch(void* const* d_in, const int* in_sizes, int n_in, void* d_out, int out_size, void* d_ws, size_t ws_size, hipStream_t stream) {
    static int grid = 0;
    if (grid == 0) {
        if (n_in != 26 || out_size != MTOK * DM || ws_size < WS_END) { fprintf(stderr, "kernel_launch: unexpected shapes (n_in %d, out %d, ws %zu < %zu)\n", n_in, out_size, ws_size, (size_t)WS_END); grid = -1; return; }
        int dev = 0, cus = 0, per_cu = 0;
        hipGetDevice(&dev); hipDeviceGetAttribute(&cus, hipDeviceAttributeMultiprocessorCount, dev);
        if (hipFuncSetAttribute((const void*)mega, hipFuncAttributeMaxDynamicSharedMemorySize, LDS_BYTES) != hipSuccess) { fprintf(stderr, "kernel_launch: hipFuncSetAttribute failed\n"); grid = -1; return; }
        if (hipOccupancyMaxActiveBlocksPerMultiprocessor(&per_cu, (const void*)mega, 512, LDS_BYTES) != hipSuccess || per_cu < 1) { fprintf(stderr, "kernel_launch: occupancy query says %d\n", per_cu); per_cu = 1; }
        (void)hipGetLastError();
        grid = cus * 1;
    }
    if (grid < 0) return;
    if (hipMemsetAsync((char*)d_ws + WS_BAR, 0, XCD_BAR_WORDS * 4, stream) != hipSuccess) { fprintf(stderr, "kernel_launch: memset failed\n"); return; }
    Args a{};
    for (int i = 0; i < 26; ++i) a.in[i] = (const float*)d_in[i];
    a.out = (float*)d_out; a.ws = (unsigned char*)d_ws;
#if MK_ONE_LAUNCH
    a.ph_lo = 0; a.ph_hi = NPHASE;
    void* args[] = {&a};
    hipError_t e = hipLaunchCooperativeKernel((const void*)mega, dim3(grid), dim3(512), args, LDS_BYTES, stream);
    if (e != hipSuccess) fprintf(stderr, "cooperative launch failed: %s (grid %d)\n", hipGetErrorString(e), grid);
#else
    for (int ph = 0; ph < NPHASE; ++ph) { a.ph_lo = ph; a.ph_hi = ph + 1; hipLaunchKernelGGL(mega, dim3(grid), dim3(512), LDS_BYTES, stream, a); }
#endif
}
```

```cpp
#include <hip/hip_runtime.h>
#include <hip/hip_cooperative_groups.h>
#include <cstdio>
#include <cstdint>
namespace cg = cooperative_groups;
namespace pg8 {
#define PG8_LAS __attribute__((address_space(3)))
typedef unsigned short bf16_t;
typedef short bf16x8 __attribute__((ext_vector_type(8)));
typedef float f32x4 __attribute__((ext_vector_type(4)));
typedef unsigned u32x4 __attribute__((ext_vector_type(4)));
constexpr int BM = 256, BK = 64, HALF = 128, HTB = HALF * BK * 2  , STAGE_BYTES = 8 * HTB, NXCD = 8, WGM = 8;

__host__ __device__ __forceinline__ int lds_byte(int r, int c) { const int st = (r >> 4) * 2 + (c >> 5), rr = r & 15, cc = c & 31, ob = rr * 64 + cc * 2; return st * 1024 + (ob ^ (((ob >> 9) & 1) << 5)); }
__host__ __device__ __forceinline__ void stage_rc(int b, int& R, int& C) { const int st = b / 1024, sb = b % 1024, swz = sb ^ (((sb >> 9) & 1) << 5); R = (st >> 1) * 16 + swz / 64; C = (st & 1) * 32 + (swz % 64) / 2; }
__host__ __device__ __forceinline__ int perm32(int rho) { const int n = rho >> 4, i = rho & 15; return 8 * (i >> 2) + 4 * n + (i & 3); }

struct Unit { int pm, pn, idx; };
struct Gemm { const bf16_t* A; const bf16_t* Bt; int M, N, K, lda; };

struct StaticOrder {
    int nM, nN, nwg, G, c;
    __host__ __device__ void init(int M, int N, int G_, int c_) { nM = M / BM; nN = N / BM; nwg = nM * nN; G = G_; c = c_; }
    __host__ __device__ bool next(int i, Unit& u) const {
        const long L = (long)i * G + c; if (L >= nwg) return false;
        int wgid = (int)L; { const int q = nwg / NXCD, r = nwg % NXCD, xcd = wgid % NXCD, off = wgid / NXCD; wgid = (xcd < r ? xcd * (q + 1) : r * (q + 1) + (xcd - r) * q) + off; }
        const int nig = WGM * nN, gid = wgid / nig, fm = gid * WGM, gsz = (nM - fm) < WGM ? (nM - fm) : WGM;
        u.pm = fm + ((wgid % nig) % gsz); u.pn = (wgid % nig) / gsz; u.idx = i; return true;
    }
    __device__ __forceinline__ void a_ready(const Unit&) const {}
    __device__ __forceinline__ void done(const Unit&) const {}
};

__device__ __forceinline__ unsigned cvt_pk_bf16(float lo, float hi) { unsigned r; asm volatile("v_cvt_pk_bf16_f32 %0, %1, %2" : "=v"(r) : "v"(lo), "v"(hi)); return r; }
template <class Epi, class Sched, bool ALIGN_EPI = false, bool SP2 = false>
__device__ __forceinline__ void gemm_phase(PG8_LAS unsigned char* lds, const Gemm g, const Sched& S, const Epi& E) {
    const int tid = threadIdx.x, wid = __builtin_amdgcn_readfirstlane(tid >> 6), lane = tid & 63, wr = wid >> 2, wc = wid & 3, fr = lane & 15, fq = lane >> 4;
    const int K = g.K, nt = K / BK;
    unsigned voffA[2], voffB[2];
#pragma unroll
    for (int i = 0; i < 2; ++i) { int R, C; stage_rc(tid * 16 + i * 8192, R, C); const int Rb = Epi::PERM ? ((R & ~31) + perm32(R & 31)) : R;
        voffA[i] = (unsigned)(R * g.lda + C) * 2u; voffB[i] = (unsigned)(Rb * K + C) * 2u; }
    const size_t kstep = (size_t)(BK * 2);
    const size_t hstep = (size_t)HALF * K * 2;
    const size_t tstep = 2 * hstep; const size_t hstepA = (size_t)HALF * g.lda * 2; const size_t tstepA = 2 * hstepA;
    const unsigned ldsw = (unsigned)wid * 1024u;
    const int aoff = lds_byte(wr * 64 + fr, fq * 8), boff = lds_byte(wc * 32 + fr, fq * 8);
#define PG8_SA(b, h) (((b) * 2 + (h)) * HTB)
#define PG8_SB(b, h) ((4 + (b) * 2 + (h)) * HTB)
#define PG8_STAGE(bufoff, gbase, voff) do { _Pragma("unroll") for (int _i = 0; _i < 2; ++_i) \
        __builtin_amdgcn_global_load_lds((const unsigned*)((const char*)(gbase) + (voff)[_i]), (PG8_LAS unsigned*)(lds + (bufoff) + ldsw + _i * 8192), 16, 0, 0); } while (0)
#define PG8_LDA(dst, b, h) do { _Pragma("unroll") for (int m = 0; m < 4; ++m) _Pragma("unroll") for (int k = 0; k < 2; ++k) dst[m][k] = *(const PG8_LAS bf16x8*)(lds + PG8_SA(b, h) + aoff + m * 2048 + k * 1024); } while (0)
#define PG8_LDB(dst, b, h) do { _Pragma("unroll") for (int n = 0; n < 2; ++n) _Pragma("unroll") for (int k = 0; k < 2; ++k) dst[n][k] = *(const PG8_LAS bf16x8*)(lds + PG8_SB(b, h) + boff + n * 2048 + k * 1024); } while (0)
#define PG8_MMA(ai, bj, At, Bt) do { __builtin_amdgcn_s_setprio(1); _Pragma("unroll") for (int m = 0; m < 4; ++m) _Pragma("unroll") for (int n = 0; n < 2; ++n) _Pragma("unroll") for (int k = 0; k < 2; ++k) \
        acc[ai][bj][m][n] = __builtin_amdgcn_mfma_f32_16x16x32_bf16(Bt[n][k], At[m][k], acc[ai][bj][m][n], 0, 0, 0); __builtin_amdgcn_s_setprio(0); } while (0)
#define PG8_WAIT_V(n) asm volatile("s_waitcnt vmcnt(" #n ")" ::: "memory")
#define PG8_WAIT_L(n) asm volatile("s_waitcnt lgkmcnt(" #n ")" ::: "memory")
#define PG8_BAR __builtin_amdgcn_s_barrier()
#define PG8_SCHED __builtin_amdgcn_sched_barrier(0)
    Unit cur, nxt; int ui = 0;
    if (!S.next(0, cur)) return;
    f32x4 acc[2][2][4][2];
#pragma unroll
    for (int a = 0; a < 2; ++a)
#pragma unroll
        for (int b = 0; b < 2; ++b)
#pragma unroll
            for (int m = 0; m < 4; ++m)
#pragma unroll
                for (int n = 0; n < 2; ++n) acc[a][b][m][n] = (f32x4){0.f, 0.f, 0.f, 0.f};
    bf16x8 At[4][2], B0[2][2], B1[2][2];
    const char* cA = (const char*)g.A + (size_t)cur.pm * tstepA; const char* cB = (const char*)g.Bt + (size_t)cur.pn * tstep;
    S.a_ready(cur);
    if constexpr (SP2) {
        PG8_STAGE(PG8_SB(0, 0), cB, voffB); PG8_STAGE(PG8_SB(0, 1), cB + hstep, voffB); PG8_STAGE(PG8_SA(0, 0), cA, voffA); PG8_STAGE(PG8_SA(0, 1), cA + hstepA, voffA);
        if constexpr (Epi::RSTD_N > 0) E.pre(S);
        if (wr == 1) PG8_BAR;
        PG8_WAIT_V(2); PG8_BAR;
        PG8_STAGE(PG8_SB(1, 0), cB + kstep, voffB); PG8_STAGE(PG8_SA(1, 0), cA + kstep, voffA); PG8_STAGE(PG8_SB(1, 1), cB + hstep + kstep, voffB);
        PG8_WAIT_V(6); PG8_BAR;
    } else {
        PG8_STAGE(PG8_SB(0, 0), cB, voffB); PG8_STAGE(PG8_SA(0, 0), cA, voffA); PG8_STAGE(PG8_SB(0, 1), cB + hstep, voffB); PG8_STAGE(PG8_SA(0, 1), cA + hstepA, voffA);
        if (wr == 1) PG8_BAR;
        PG8_WAIT_V(4); PG8_BAR;
        PG8_STAGE(PG8_SB(1, 0), cB + kstep, voffB); PG8_STAGE(PG8_SA(1, 0), cA + kstep, voffA); PG8_STAGE(PG8_SB(1, 1), cB + hstep + kstep, voffB);
        PG8_WAIT_V(6); PG8_BAR;
    }
    for (;;) {
        const bool has_next = S.next(ui + 1, nxt);
        const char* nA = has_next ? (const char*)g.A + (size_t)nxt.pm * tstepA : cA; const char* nB = has_next ? (const char*)g.Bt + (size_t)nxt.pn * tstep : cB;
#pragma unroll 1
        for (int t = 0; t < nt; t += 2) {
            const bool last = (t == nt - 2);
            const char* a1 = cA + (size_t)(t + 1) * kstep;
            const char* a2 = last ? nA : cA + (size_t)(t + 2) * kstep; const char* b2 = last ? nB : cB + (size_t)(t + 2) * kstep;
            const char* a3 = a2 + kstep; const char* b3 = b2 + kstep;
            if (last && has_next) S.a_ready(nxt);
            if constexpr (SP2) {
            PG8_LDB(B0, 0, 0); PG8_LDB(B1, 0, 1); PG8_SCHED; PG8_LDA(At, 0, 0); PG8_STAGE(PG8_SA(1, 1), a1 + hstepA, voffA);
            PG8_WAIT_V(8); PG8_WAIT_L(0); PG8_BAR; PG8_MMA(0, 0, At, B0); PG8_MMA(0, 1, At, B1); PG8_BAR; PG8_SCHED;
            PG8_LDA(At, 0, 1); PG8_STAGE(PG8_SB(0, 0), b2, voffB); PG8_STAGE(PG8_SB(0, 1), b2 + hstep, voffB); PG8_STAGE(PG8_SA(0, 0), a2, voffA);
            PG8_WAIT_V(8); PG8_WAIT_L(0); PG8_BAR; PG8_MMA(1, 0, At, B0); PG8_MMA(1, 1, At, B1); PG8_BAR; PG8_SCHED;
            PG8_LDB(B0, 1, 0); PG8_LDB(B1, 1, 1); PG8_SCHED; PG8_LDA(At, 1, 0); PG8_STAGE(PG8_SA(0, 1), a2 + hstepA, voffA);
            PG8_WAIT_V(8); PG8_WAIT_L(0); PG8_BAR; PG8_MMA(0, 0, At, B0); PG8_MMA(0, 1, At, B1); PG8_BAR; PG8_SCHED;
            PG8_LDA(At, 1, 1); PG8_STAGE(PG8_SB(1, 0), b3, voffB); PG8_STAGE(PG8_SB(1, 1), b3 + hstep, voffB); PG8_STAGE(PG8_SA(1, 0), a3, voffA);
            PG8_WAIT_V(8); PG8_WAIT_L(0); PG8_BAR; PG8_MMA(1, 0, At, B0); PG8_MMA(1, 1, At, B1); PG8_BAR; PG8_SCHED;
            } else {
            PG8_LDB(B0, 0, 0); PG8_SCHED; PG8_LDA(At, 0, 0); PG8_STAGE(PG8_SA(1, 1), a1 + hstepA, voffA);
            PG8_WAIT_L(8); PG8_BAR; PG8_WAIT_L(0); PG8_MMA(0, 0, At, B0); PG8_BAR; PG8_SCHED;
            PG8_LDB(B1, 0, 1); PG8_STAGE(PG8_SB(0, 0), b2, voffB);
            PG8_BAR; PG8_WAIT_L(0); PG8_MMA(0, 1, At, B1); PG8_BAR;
            PG8_LDA(At, 0, 1); PG8_STAGE(PG8_SA(0, 0), a2, voffA);
            PG8_BAR; PG8_WAIT_L(0); PG8_MMA(1, 0, At, B0); PG8_BAR; PG8_SCHED;
            PG8_STAGE(PG8_SB(0, 1), b2 + hstep, voffB);
            PG8_WAIT_V(6); PG8_BAR; PG8_MMA(1, 1, At, B1); PG8_BAR;
            PG8_LDB(B0, 1, 0); PG8_SCHED; PG8_LDA(At, 1, 0); PG8_STAGE(PG8_SA(0, 1), a2 + hstepA, voffA);
            PG8_WAIT_L(8); PG8_BAR; PG8_WAIT_L(0); PG8_MMA(0, 0, At, B0); PG8_BAR; PG8_SCHED;
            PG8_LDB(B1, 1, 1); PG8_STAGE(PG8_SB(1, 0), b3, voffB);
            PG8_BAR; PG8_WAIT_L(0); PG8_MMA(0, 1, At, B1); PG8_BAR;
            PG8_LDA(At, 1, 1); PG8_STAGE(PG8_SA(1, 0), a3, voffA);
            PG8_BAR; PG8_WAIT_L(0); PG8_MMA(1, 0, At, B0); PG8_BAR; PG8_SCHED;
            PG8_STAGE(PG8_SB(1, 1), b3 + hstep, voffB);
            PG8_WAIT_V(6); PG8_BAR; PG8_MMA(1, 1, At, B1); PG8_BAR;
            }
        }
        if constexpr (ALIGN_EPI) { if (wr == 0) PG8_BAR; }
        if constexpr (!Epi::AFTER_DRAIN) { E(acc, cur, wr, wc, fr, fq); S.done(cur); }
        if (!has_next) break;
#pragma unroll
        for (int a = 0; a < 2; ++a)
#pragma unroll
            for (int b = 0; b < 2; ++b)
#pragma unroll
                for (int m = 0; m < 4; ++m)
#pragma unroll
                    for (int n = 0; n < 2; ++n) acc[a][b][m][n] = (f32x4){0.f, 0.f, 0.f, 0.f};
        cur = nxt; cA = nA; cB = nB; ++ui;
        if constexpr (ALIGN_EPI) { if (wr == 1) PG8_BAR; }
    }
    PG8_WAIT_V(0);
    if constexpr (!ALIGN_EPI) { if (wr == 0) PG8_BAR; }
    PG8_BAR;
    if constexpr (Epi::AFTER_DRAIN) { E.fused(acc, cur, wr, wc, fr, fq, lds, wid, lane); S.done(cur); }
#undef PG8_SA
#undef PG8_SB
#undef PG8_STAGE
#undef PG8_LDA
#undef PG8_LDB
#undef PG8_MMA
#undef PG8_WAIT_V
#undef PG8_WAIT_L
#undef PG8_BAR
#undef PG8_SCHED
}
}

using pg8::bf16_t; using pg8::bf16x8; using pg8::f32x4; using pg8::u32x4;
#define LAS __attribute__((address_space(3)))
typedef unsigned u32x2 __attribute__((ext_vector_type(2)));

constexpr int MTOK = 32768, DM = 1024, SEQ = 2048, NBATCH = 16, FF = 2816;
constexpr float EPS = 1e-6f;
constexpr int LDS_BYTES = 147456;

constexpr size_t WS_W_IN0  = 0;
constexpr size_t WS_W_OUT0 = WS_W_IN0  + (size_t)3072 * 1024 * 2;
constexpr size_t WS_W_GU0  = WS_W_OUT0 + (size_t)1024 * 1024 * 2;
constexpr size_t WS_W_D0   = WS_W_GU0  + (size_t)5632 * 1024 * 2;
constexpr size_t WS_W_IN1  = WS_W_D0   + (size_t)1024 * 2816 * 2;
constexpr size_t WS_W_OUT1 = WS_W_IN1  + (size_t)1792 * 1024 * 2;
constexpr size_t WS_W_GU1  = WS_W_OUT1 + (size_t)1024 * 1024 * 2;
constexpr size_t WS_W_D1   = WS_W_GU1  + (size_t)5632 * 1024 * 2;
constexpr size_t WS_W_UQ   = WS_W_D1   + (size_t)1024 * 2816 * 2;
constexpr size_t WS_W_UKV  = WS_W_UQ   + (size_t)768 * 384 * 2;
constexpr size_t WS_SS     = WS_W_UKV  + (size_t)1024 * 256 * 2;
constexpr size_t WS_ROPE   = WS_SS     + (size_t)7 * MTOK * 4;
constexpr size_t WS_XB     = WS_ROPE   + (size_t)MTOK * 64 * 4;
constexpr size_t WS_CAT    = WS_XB     + (size_t)MTOK * 1024 * 2;
constexpr size_t WS_R1     = WS_CAT    + (size_t)MTOK * 1024 * 2;
constexpr size_t R1_BYTES  = (size_t)220 * 1024 * 1024;
constexpr size_t WS_BAR    = WS_R1 + R1_BYTES;
constexpr size_t WS_END    = WS_BAR + 16384;
constexpr size_t R1_HGLU = 0;
constexpr size_t R1_PQKV = R1_HGLU + (size_t)MTOK * 512 * 2;
constexpr size_t R1_Q    = R1_PQKV + (size_t)MTOK * 768 * 2;
constexpr size_t R1_KB   = R1_Q    + (size_t)MTOK * 768 * 2;
constexpr size_t R1_VT   = R1_KB   + (size_t)MTOK * 4 * 192 * 2;
static_assert(R1_VT + (size_t)MTOK * 512 * 2 <= R1_BYTES, "R1 too small");
static_assert((size_t)MTOK * 3072 * 2 <= R1_BYTES, "R1 too small for p_even");

struct Args { const float* in[26]; float* out; unsigned char* ws; int ph_lo, ph_hi; };

__device__ __forceinline__ float bf2f(bf16_t b) { return __uint_as_float((unsigned)b << 16); }
__device__ __forceinline__ float bflo(unsigned u) { return __uint_as_float(u << 16); }
__device__ __forceinline__ float bfhi(unsigned u) { return __uint_as_float(u & 0xffff0000u); }
__device__ __forceinline__ unsigned pk2(float lo, float hi) { return pg8::cvt_pk_bf16(lo, hi); }
__device__ __forceinline__ bf16_t f2bf(float f) { return (bf16_t)(pk2(f, 0.f) & 0xffffu); }
__device__ __forceinline__ float sigmoidf_(float x) { return __builtin_amdgcn_rcpf(1.0f + __expf(-x)); }
__device__ __forceinline__ float siluf_(float x) { return x * sigmoidf_(x); }
__device__ __forceinline__ float gelu_tanh(float x) { const float z = 1.5957691216057308f * (x + 0.044715f * x * x * x); return x * sigmoidf_(z); }
__device__ __forceinline__ void wg_barrier() { __syncthreads(); }
typedef unsigned u32x2s __attribute__((ext_vector_type(2)));
__device__ __forceinline__ float xor32_max(float x) { const u32x2s r = __builtin_amdgcn_permlane32_swap(__float_as_uint(x), __float_as_uint(x), false, false); return __builtin_fmaxf(__uint_as_float(r.x), __uint_as_float(r.y)); }
__device__ __forceinline__ float xor16_max(float x) { const u32x2s r = __builtin_amdgcn_permlane16_swap(__float_as_uint(x), __float_as_uint(x), false, false); return __builtin_fmaxf(__uint_as_float(r.x), __uint_as_float(r.y)); }
__device__ __forceinline__ f32x4 mfma16(bf16x8 a, bf16x8 b, f32x4 c) { return __builtin_amdgcn_mfma_f32_16x16x32_bf16(a, b, c, 0, 0, 0); }
__device__ __forceinline__ bf16x8 lds_frag(LAS unsigned char* base, int byte_off) { return *(const LAS bf16x8*)(base + byte_off); }

struct EpiInEven {
    static constexpr bool PERM = true, AFTER_DRAIN = false; static constexpr int RSTD_N = 1024; LAS float* rt; const float* ssrc;
    template <class Sched> __device__ __forceinline__ void pre(const Sched& S) const { pg8::Unit u; for (int i = 0; i < 15 && S.next(i, u); ++i) if (threadIdx.x < 256) rt[i * 256 + threadIdx.x] = rsqrtf(ssrc[u.pm * 256 + threadIdx.x] * (1.0f / (float)RSTD_N) + EPS); }
    bf16_t* O; const float* ss;
    __device__ __forceinline__ void operator()(const f32x4 (&acc)[2][2][4][2], const pg8::Unit& u, int wr, int wc, int fr, int fq) const {
        const int row0 = u.pm * 256 + wr * 64 + fr, col0 = u.pn * 256 + wc * 32 + 8 * fq; const bool act = u.pn >= 8;
#pragma unroll
        for (int ai = 0; ai < 2; ++ai)
#pragma unroll
            for (int m = 0; m < 4; ++m) { const int row = row0 + ai * 128 + m * 16; const float rstd = rt[u.idx * 256 + (row - u.pm * 256)];
#pragma unroll
                for (int bj = 0; bj < 2; ++bj) { f32x4 v0 = acc[ai][bj][m][0] * rstd, v1 = acc[ai][bj][m][1] * rstd;
                    if (act) {
#pragma unroll
                        for (int j = 0; j < 4; ++j) { v0[j] = gelu_tanh(v0[j]); v1[j] = gelu_tanh(v1[j]); } }
                    u32x4 w; w.x = pk2(v0[0], v0[1]); w.y = pk2(v0[2], v0[3]); w.z = pk2(v1[0], v1[1]); w.w = pk2(v1[2], v1[3]);
                    __builtin_nontemporal_store(w, (u32x4*)(O + (size_t)row * 3072 + col0 + bj * 128)); } }
    }
};
struct EpiResid {
    static constexpr bool PERM = true, AFTER_DRAIN = false; static constexpr int RSTD_N = 0;
    bf16_t* xb; float* ss;
    __device__ __forceinline__ void operator()(const f32x4 (&acc)[2][2][4][2], const pg8::Unit& u, int wr, int wc, int fr, int fq) const {
        const int row0 = u.pm * 256 + wr * 64 + fr, col0 = u.pn * 256 + wc * 32 + 8 * fq;
#pragma unroll
        for (int ai = 0; ai < 2; ++ai) {
            u32x4 r[4][2];
#pragma unroll
            for (int m = 0; m < 4; ++m)
#pragma unroll
                for (int bj = 0; bj < 2; ++bj) r[m][bj] = *(const u32x4*)(xb + (size_t)(row0 + ai * 128 + m * 16) * 1024 + col0 + bj * 128);
#pragma unroll
            for (int m = 0; m < 4; ++m) { const int row = row0 + ai * 128 + m * 16; bf16_t* xp = xb + (size_t)row * 1024 + col0; float s = 0.f;
#pragma unroll
                for (int bj = 0; bj < 2; ++bj) { const u32x4 q = r[m][bj];
                    u32x4 w; w.x = pk2(bflo(q.x) + acc[ai][bj][m][0][0], bfhi(q.x) + acc[ai][bj][m][0][1]); w.y = pk2(bflo(q.y) + acc[ai][bj][m][0][2], bfhi(q.y) + acc[ai][bj][m][0][3]);
                    w.z = pk2(bflo(q.z) + acc[ai][bj][m][1][0], bfhi(q.z) + acc[ai][bj][m][1][1]); w.w = pk2(bflo(q.w) + acc[ai][bj][m][1][2], bfhi(q.w) + acc[ai][bj][m][1][3]);
                    __builtin_nontemporal_store(w, (u32x4*)(xp + bj * 128));
                    s += (bflo(w.x) * bflo(w.x) + bfhi(w.x) * bfhi(w.x)) + (bflo(w.y) * bflo(w.y) + bfhi(w.y) * bfhi(w.y)) + (bflo(w.z) * bflo(w.z) + bfhi(w.z) * bfhi(w.z)) + (bflo(w.w) * bflo(w.w) + bfhi(w.w) * bfhi(w.w)); }
                s += __shfl_xor(s, 16); s += __shfl_xor(s, 32);
                if (fq == 0) unsafeAtomicAdd(ss + row, s); }
        }
    }
};
struct EpiSwiglu {
    static constexpr bool PERM = true, AFTER_DRAIN = false; static constexpr int RSTD_N = 1024; LAS float* rt; const float* ssrc;
    template <class Sched> __device__ __forceinline__ void pre(const Sched& S) const { pg8::Unit u; for (int i = 0; i < 15 && S.next(i, u); ++i) if (threadIdx.x < 256) rt[i * 256 + threadIdx.x] = rsqrtf(ssrc[u.pm * 256 + threadIdx.x] * (1.0f / (float)RSTD_N) + EPS); }
    bf16_t* O; const float* ss;
    __device__ __forceinline__ void operator()(const f32x4 (&acc)[2][2][4][2], const pg8::Unit& u, int wr, int wc, int fr, int fq) const {
        const int row0 = u.pm * 256 + wr * 64 + fr, col0 = u.pn * 128 + wc * 32 + 8 * fq;
#pragma unroll
        for (int ai = 0; ai < 2; ++ai)
#pragma unroll
            for (int m = 0; m < 4; ++m) { const int row = row0 + ai * 128 + m * 16; const float rstd = rt[u.idx * 256 + (row - u.pm * 256)];
                float h[8];
#pragma unroll
                for (int n = 0; n < 2; ++n)
#pragma unroll
                    for (int j = 0; j < 4; ++j) { const float gv = acc[ai][0][m][n][j] * rstd, uv = acc[ai][1][m][n][j] * rstd; h[n * 4 + j] = siluf_(gv) * uv; }
                u32x4 w; w.x = pk2(h[0], h[1]); w.y = pk2(h[2], h[3]); w.z = pk2(h[4], h[5]); w.w = pk2(h[6], h[7]);
                __builtin_nontemporal_store(w, (u32x4*)(O + (size_t)row * FF + col0)); }
    }
};
struct EpiInOdd {
    static constexpr bool PERM = true, AFTER_DRAIN = false; static constexpr int RSTD_N = 1024; LAS float* rt; const float* ssrc;
    template <class Sched> __device__ __forceinline__ void pre(const Sched& S) const { pg8::Unit u; for (int i = 0; i < 15 && S.next(i, u); ++i) if (threadIdx.x < 256) rt[i * 256 + threadIdx.x] = rsqrtf(ssrc[u.pm * 256 + threadIdx.x] * (1.0f / (float)RSTD_N) + EPS); }
    bf16_t* hglu; bf16_t* pqkv; const float* ss; float* ssq; float* sskv; int thr, off0, off1;
    __device__ __forceinline__ void operator()(const f32x4 (&acc)[2][2][4][2], const pg8::Unit& u, int wr, int wc, int fr, int fq) const {
        const int row0 = u.pm * 256 + wr * 64 + fr; const int lpn = u.pn < thr ? u.pn + off0 : u.pn + off1;
#pragma unroll
        for (int ai = 0; ai < 2; ++ai)
#pragma unroll
            for (int m = 0; m < 4; ++m) { const int row = row0 + ai * 128 + m * 16; const float rstd = rt[u.idx * 256 + (row - u.pm * 256)];
                if (lpn < 4) {
                    float h[8];
#pragma unroll
                    for (int n = 0; n < 2; ++n)
#pragma unroll
                        for (int j = 0; j < 4; ++j) { const float av = acc[ai][0][m][n][j] * rstd, gv = acc[ai][1][m][n][j] * rstd; h[n * 4 + j] = av * sigmoidf_(gv); }
                    u32x4 w; w.x = pk2(h[0], h[1]); w.y = pk2(h[2], h[3]); w.z = pk2(h[4], h[5]); w.w = pk2(h[6], h[7]);
                    __builtin_nontemporal_store(w, (u32x4*)(hglu + (size_t)row * 512 + lpn * 128 + wc * 32 + 8 * fq));
                } else {
                    const int t = lpn - 4;
#pragma unroll
                    for (int bj = 0; bj < 2; ++bj) { const f32x4 v0 = acc[ai][bj][m][0] * rstd, v1 = acc[ai][bj][m][1] * rstd;
                        u32x4 w; w.x = pk2(v0[0], v0[1]); w.y = pk2(v0[2], v0[3]); w.z = pk2(v1[0], v1[1]); w.w = pk2(v1[2], v1[3]);
                        __builtin_nontemporal_store(w, (u32x4*)(pqkv + (size_t)row * 768 + t * 256 + bj * 128 + wc * 32 + 8 * fq));
                        const int which = t * 2 + bj;
                        if (which < 5) { float s = (v0[0] * v0[0] + v0[1] * v0[1]) + (v0[2] * v0[2] + v0[3] * v0[3]) + (v1[0] * v1[0] + v1[1] * v1[1]) + (v1[2] * v1[2] + v1[3] * v1[3]);
                            s += __shfl_xor(s, 16); s += __shfl_xor(s, 32);
                            if (fq == 0) unsafeAtomicAdd((which < 3 ? ssq : sskv) + row, s); } } } }
    }
};
constexpr float QSCALE = 0.07216878364870322f * 1.4426950408889634f;
struct EpiUq {
    static constexpr bool PERM = true, AFTER_DRAIN = false; static constexpr int RSTD_N = 384; LAS float* rt; const float* ssrc;
    template <class Sched> __device__ __forceinline__ void pre(const Sched& S) const { pg8::Unit u; for (int i = 0; i < 15 && S.next(i, u); ++i) if (threadIdx.x < 256) rt[i * 256 + threadIdx.x] = rsqrtf(ssrc[u.pm * 256 + threadIdx.x] * (1.0f / (float)RSTD_N) + EPS); }
    bf16_t* Q; const float* ssq;
    __device__ __forceinline__ void operator()(const f32x4 (&acc)[2][2][4][2], const pg8::Unit& u, int wr, int wc, int fr, int fq) const {
        const int row0 = u.pm * 256 + wr * 64 + fr, col0 = u.pn * 256 + wc * 32 + 8 * fq;
#pragma unroll
        for (int ai = 0; ai < 2; ++ai)
#pragma unroll
            for (int m = 0; m < 4; ++m) { const int row = row0 + ai * 128 + m * 16; const float rstd = rt[u.idx * 256 + (row - u.pm * 256)] * QSCALE;
#pragma unroll
                for (int bj = 0; bj < 2; ++bj) { const f32x4 v0 = acc[ai][bj][m][0] * rstd, v1 = acc[ai][bj][m][1] * rstd;
                    u32x4 w; w.x = pk2(v0[0], v0[1]); w.y = pk2(v0[2], v0[3]); w.z = pk2(v1[0], v1[1]); w.w = pk2(v1[2], v1[3]);
                    __builtin_nontemporal_store(w, (u32x4*)(Q + (size_t)row * 768 + col0 + bj * 128)); } }
    }
};
struct EpiUkv {
    static constexpr bool PERM = true, AFTER_DRAIN = false; static constexpr int RSTD_N = 256; LAS float* rt; const float* ssrc;
    template <class Sched> __device__ __forceinline__ void pre(const Sched& S) const { pg8::Unit u; for (int i = 0; i < 15 && S.next(i, u); ++i) if (threadIdx.x < 256) rt[i * 256 + threadIdx.x] = rsqrtf(ssrc[u.pm * 256 + threadIdx.x] * (1.0f / (float)RSTD_N) + EPS); }
    bf16_t* Kb; bf16_t* Vt; const float* sskv;
    __device__ __forceinline__ void operator()(const f32x4 (&acc)[2][2][4][2], const pg8::Unit& u, int wr, int wc, int fr, int fq) const {
        const int row0 = u.pm * 256 + wr * 64 + fr, h = u.pn;
#pragma unroll
        for (int ai = 0; ai < 2; ++ai)
#pragma unroll
            for (int m = 0; m < 4; ++m) { const int row = row0 + ai * 128 + m * 16; const float rstd = rt[u.idx * 256 + (row - u.pm * 256)];
                const int b = row >> 11, t = row & 2047; const size_t bh = (size_t)(b * 4 + h);
                { const f32x4 v0 = acc[ai][0][m][0] * rstd, v1 = acc[ai][0][m][1] * rstd;
                  u32x4 w; w.x = pk2(v0[0], v0[1]); w.y = pk2(v0[2], v0[3]); w.z = pk2(v1[0], v1[1]); w.w = pk2(v1[2], v1[3]);
                  __builtin_nontemporal_store(w, (u32x4*)(Kb + (bh * 2048 + t) * 192 + wc * 32 + 8 * fq)); }
{ const f32x4 v0 = acc[ai][1][m][0] * rstd, v1 = acc[ai][1][m][1] * rstd;
                  u32x4 w; w.x = pk2(v0[0], v0[1]); w.y = pk2(v0[2], v0[3]); w.z = pk2(v1[0], v1[1]); w.w = pk2(v1[2], v1[3]);
                  __builtin_nontemporal_store(w, (u32x4*)(Vt + (bh * 2048 + t) * 128 + wc * 32 + 8 * fq)); } }
    }
};

struct EpiNull {
    static constexpr bool PERM = true, AFTER_DRAIN = false; static constexpr int RSTD_N = 0;
    float* sink;
    __device__ __forceinline__ void operator()(const f32x4 (&acc)[2][2][4][2], const pg8::Unit& u, int wr, int wc, int fr, int fq) const {
        f32x4 s = (f32x4){0.f, 0.f, 0.f, 0.f};
#pragma unroll
        for (int ai = 0; ai < 2; ++ai)
#pragma unroll
            for (int bj = 0; bj < 2; ++bj)
#pragma unroll
                for (int m = 0; m < 4; ++m) { s += acc[ai][bj][m][0]; s += acc[ai][bj][m][1]; }
        if (s[0] + s[1] + s[2] + s[3] == 12345.678f) sink[0] = 1.f;
    }
};
struct ListOrder {
    int nM, nN, first, cnt;
    __device__ bool next(int i, pg8::Unit& u) const {
        if (i >= cnt) return false;
        const int wgid = first + i, nig = pg8::WGM * nN, gid = wgid / nig, fm = gid * pg8::WGM, gsz = (nM - fm) < pg8::WGM ? (nM - fm) : pg8::WGM;
        u.pm = fm + ((wgid % nig) % gsz); u.pn = (wgid % nig) / gsz; u.idx = i; return true;
    }
    __device__ __forceinline__ void a_ready(const pg8::Unit&) const {}
    __device__ __forceinline__ void done(const pg8::Unit&) const {}
};
template <class Epi, class Sched>
__device__ __forceinline__ void run_gemm_s(LAS unsigned char* lds, const bf16_t* A, int lda, const bf16_t* Bt, int N, int K, Epi E, const Sched& S) {
    pg8::Gemm g; g.A = A; g.Bt = Bt; g.M = MTOK; g.N = N; g.K = K; g.lda = lda;
    if constexpr (Epi::RSTD_N > 0) E.rt = (LAS float*)(lds + pg8::STAGE_BYTES);
    pg8::gemm_phase<Epi, Sched, true, true>(lds, g, S, E);
}
template <class Epi>
__device__ __forceinline__ void run_gemm(LAS unsigned char* lds, const bf16_t* A, int lda, const bf16_t* Bt, int N, int K, Epi E, int stagger = 0) {
    pg8::Gemm g; g.A = A; g.Bt = Bt; g.M = MTOK; g.N = N; g.K = K; g.lda = lda;
    pg8::StaticOrder S; S.init(MTOK, N, (int)gridDim.x, (int)blockIdx.x);
    if constexpr (Epi::RSTD_N > 0) E.rt = (LAS float*)(lds + pg8::STAGE_BYTES);
    pg8::gemm_phase<Epi, pg8::StaticOrder, true, true>(lds, g, S, E);
}
#define XB_TMO      128
#define XB_XCNT(j)  (256  + 64 * (j))
#define XB_XSUB(j)  (1280 + 64 * (j))
#define XB_XGEN(j)  (2304 + 64 * (j))
#define XB_TOP      3328
#define XB_TOPGEN   3392
#define XCD_BAR_WORDS 3456
#define XB_SPIN_CAP (1u << 18)

__device__ __forceinline__ unsigned xb_ld(unsigned* p)              { return __hip_atomic_load(p, __ATOMIC_RELAXED, __HIP_MEMORY_SCOPE_AGENT); }
__device__ __forceinline__ unsigned xb_add(unsigned* p, unsigned v) { return __hip_atomic_fetch_add(p, v, __ATOMIC_RELAXED, __HIP_MEMORY_SCOPE_AGENT); }
__device__ __forceinline__ unsigned xb_xcc_id() { return (unsigned)__builtin_amdgcn_s_getreg((3 << 11) | 20) & 0xFu; }
#define XB_SPIN(cond, bar) do { unsigned _sp = 0; while (cond) { __builtin_amdgcn_s_sleep(1); \
    if ((++_sp & 255u) == 0u) { if (xb_ld(&(bar)[XB_TMO])) break; if (_sp > XB_SPIN_CAP) { atomicAdd(&(bar)[XB_TMO], 1u); break; } } } } while (0)

struct XcdBarrier {
    unsigned* bar; unsigned x;
    volatile LAS unsigned* st;
};

__device__ __forceinline__ XcdBarrier xcd_barrier_post(unsigned* bar, volatile LAS unsigned* st) {
    XcdBarrier b; b.bar = bar; b.x = xb_xcc_id(); b.st = st;
    if (threadIdx.x == 0) (void)xb_add(&bar[XB_XCNT(b.x)], 1u);
    return b;
}
__device__ __forceinline__ void xcd_barrier_complete(unsigned* bar, unsigned x, unsigned& nloc, unsigned& nx) {
    const unsigned G = gridDim.x * gridDim.y * gridDim.z;
    unsigned sum, cnt, mine, sp = 0u;
    for (;;) {
        sum = 0u; cnt = 0u; mine = 0u;
#pragma unroll
        for (unsigned j = 0; j < 16; ++j) { const unsigned c = xb_ld(&bar[XB_XCNT(j)]); sum += c; cnt += (c > 0u) ? 1u : 0u; mine = (j == x) ? c : mine; }
        if (sum == G) break;
        __builtin_amdgcn_s_sleep(1);
        if ((++sp & 255u) == 0u) { if (xb_ld(&bar[XB_TMO])) break; if (sp > XB_SPIN_CAP) { atomicAdd(&bar[XB_TMO], 1u); break; } }
    }
    nloc = mine > 0u ? mine : 1u; nx = cnt > 0u ? cnt : 1u;
}

__device__ __forceinline__ void xcd_barrier(const XcdBarrier& b) {
    asm volatile("s_waitcnt vmcnt(0)" ::: "memory");
    __syncthreads();
    if (threadIdx.x == 0) {
        unsigned* bar = b.bar;
        __builtin_amdgcn_s_waitcnt(0);
        unsigned nloc = b.st[0], nx = b.st[1];
        if (nloc == 0u) { xcd_barrier_complete(bar, b.x, nloc, nx); b.st[0] = nloc; b.st[1] = nx; }
        const unsigned old = xb_add(&bar[XB_XSUB(b.x)], 1u);
        const unsigned gen = old / nloc;
        if (old + 1u == (gen + 1u) * nloc) {
            __builtin_amdgcn_fence(__ATOMIC_RELEASE, "agent");
            asm volatile("s_waitcnt vmcnt(0)" ::: "memory");
            const unsigned og = xb_add(&bar[XB_TOP], 1u);
            const unsigned tg = og / nx;
            if (og + 1u == (tg + 1u) * nx) xb_add(&bar[XB_TOPGEN], 1u);
            else XB_SPIN(xb_ld(&bar[XB_TOPGEN]) == tg, bar);
            __builtin_amdgcn_fence(__ATOMIC_ACQUIRE, "agent");
            xb_add(&bar[XB_XGEN(b.x)], 1u);
            asm volatile("s_waitcnt vmcnt(0)" ::: "memory");
        } else {
            XB_SPIN(xb_ld(&bar[XB_XGEN(b.x)]) == gen, bar);
            __builtin_amdgcn_fence(__ATOMIC_ACQUIRE, "agent");
            asm volatile("s_waitcnt vmcnt(0)" ::: "memory");
        }
    }
    __syncthreads();
}

__device__ __forceinline__ void tr_item(const float* W, int ld, int col0, int k0, const float* gain, bf16_t* WT, int K, int nrow0, LAS float* scr, int lane) {
    const float keep = col0 >= 0 ? 1.0f : 0.0f; const int colc = col0 >= 0 ? col0 : 0; const int c = lane & 7;
    f32x4 g0 = (f32x4){keep, keep, keep, keep}, g1 = g0;
    if (gain) { g0 = *(const f32x4*)(gain + k0 + 8 * c) * keep; g1 = *(const f32x4*)(gain + k0 + 8 * c + 4) * keep; }
#pragma unroll 8
    for (int i = 0; i < 32; ++i) { const int kk = 2 * i + (lane >> 5); scr[kk * 33 + (lane & 31)] = W[(size_t)(k0 + kk) * ld + colc + (lane & 31)]; }
    asm volatile("s_waitcnt lgkmcnt(0)" ::: "memory");
#pragma unroll
    for (int j = 0; j < 4; ++j) { const int n = (lane >> 3) + 8 * j; const LAS float* s = scr + (8 * c) * 33 + n;
        u32x4 o; o.x = pk2(s[0 * 33] * g0[0], s[1 * 33] * g0[1]); o.y = pk2(s[2 * 33] * g0[2], s[3 * 33] * g0[3]); o.z = pk2(s[4 * 33] * g1[0], s[5 * 33] * g1[1]); o.w = pk2(s[6 * 33] * g1[2], s[7 * 33] * g1[3]);
        *(u32x4*)(WT + (size_t)(nrow0 + n) * K + k0 + 8 * c) = o; }
    asm volatile("s_waitcnt lgkmcnt(0)" ::: "memory");
}
__device__ __forceinline__ void convert_weights(const Args& a, LAS unsigned char* lds, int lo, int hi, int gw, int NGW) {
    const int tid = threadIdx.x, wid = tid >> 6, lane = tid & 63;
    unsigned char* ws = a.ws;
    LAS float* scr = (LAS float*)(lds + wid * 8704);
    constexpr int I0 = 1536, I1 = 512, I2 = 2816, I3 = 1408, I4 = 896, I5 = 512, I6 = 2816, I7 = 1408, I8 = 144, I9 = 128;
    for (int it = lo + gw; it < hi; it += NGW) {
        int r = it;
        if (r < I0) { const int kb = r / 96, nb = r % 96; tr_item(a.in[7], 3072, nb * 32, kb * 64, a.in[2], (bf16_t*)(ws + WS_W_IN0), 1024, nb * 32, scr, lane); continue; } r -= I0;
        if (r < I1) { const int kb = r / 32, nb = r % 32; tr_item(a.in[8], 1024, nb * 32, kb * 64, nullptr, (bf16_t*)(ws + WS_W_OUT0), 1024, nb * 32, scr, lane); continue; } r -= I1;
        if (r < I2) { const int kb = r / 176, nb = r % 176, n0 = nb * 32, tile = n0 >> 8, rr = n0 & 255;
            tr_item(rr < 128 ? a.in[4] : a.in[5], FF, tile * 128 + (rr & 127), kb * 64, a.in[3], (bf16_t*)(ws + WS_W_GU0), 1024, n0, scr, lane); continue; } r -= I2;
        if (r < I3) { const int kb = r / 32, nb = r % 32; tr_item(a.in[6], 1024, nb * 32, kb * 64, nullptr, (bf16_t*)(ws + WS_W_D0), FF, nb * 32, scr, lane); continue; } r -= I3;
        if (r < I4) { const int kb = r / 56, nb = r % 56, n0 = nb * 32; int col;
            { const int pt = n0 >> 8, rr = n0 & 255, lt = pt < 3 ? pt : (pt < 6 ? pt + 1 : 3), ln = lt * 256 + rr;
              if (lt < 4) col = rr < 128 ? lt * 128 + rr : 512 + lt * 128 + (rr - 128); else col = ln < 1728 ? ln : -1; }
            tr_item(a.in[15], 1728, col, kb * 64, a.in[2] + 1024, (bf16_t*)(ws + WS_W_IN1), 1024, n0, scr, lane); continue; } r -= I4;
        if (r < I5) { const int kb = r / 32, nb = r % 32; tr_item(a.in[16], 1024, nb * 32, kb * 64, nullptr, (bf16_t*)(ws + WS_W_OUT1), 1024, nb * 32, scr, lane); continue; } r -= I5;
        if (r < I6) { const int kb = r / 176, nb = r % 176, n0 = nb * 32, tile = n0 >> 8, rr = n0 & 255;
            tr_item((rr < 128 ? a.in[4] : a.in[5]) + (size_t)1024 * FF, FF, tile * 128 + (rr & 127), kb * 64, a.in[3] + 1024, (bf16_t*)(ws + WS_W_GU1), 1024, n0, scr, lane); continue; } r -= I6;
        if (r < I7) { const int kb = r / 32, nb = r % 32; tr_item(a.in[6] + (size_t)FF * 1024, 1024, nb * 32, kb * 64, nullptr, (bf16_t*)(ws + WS_W_D1), FF, nb * 32, scr, lane); continue; } r -= I7;
        if (r < I8) { const int kb = r / 24, nb = r % 24; tr_item(a.in[22], 768, nb * 32, kb * 64, a.in[21], (bf16_t*)(ws + WS_W_UQ), 384, nb * 32, scr, lane); continue; } r -= I8;
        { const int kb = r / 32, nb = r % 32; tr_item(a.in[24], 1024, nb * 32, kb * 64, a.in[23], (bf16_t*)(ws + WS_W_UKV), 256, nb * 32, scr, lane); }
    }
}
constexpr int WCONV_FIRST = 1536, WCONV_ALL = 1536 + 512 + 2816 + 1408 + 896 + 512 + 2816 + 1408 + 144 + 128;
__device__ __forceinline__ void phase_prologue(const Args& a, LAS unsigned char* lds) {
    const int tid = threadIdx.x, wid = tid >> 6, lane = tid & 63;
    const int gw = blockIdx.x * 8 + wid, NGW = gridDim.x * 8;
    unsigned char* ws = a.ws;
    convert_weights(a, lds, 0, WCONV_ALL, gw, NGW);
    float* ss = (float*)(ws + WS_SS);
    bf16_t* xb = (bf16_t*)(ws + WS_XB);
    for (int row0 = gw; row0 < MTOK; row0 += 4 * NGW) {
        f32x4 v[4][4];
#pragma unroll
        for (int r = 0; r < 4; ++r) { const int row = (row0 + r * NGW < MTOK) ? row0 + r * NGW : row0; const f32x4* xr = (const f32x4*)(a.in[0] + (size_t)row * 1024) + lane;
#pragma unroll
            for (int j = 0; j < 4; ++j) v[r][j] = __builtin_nontemporal_load(xr + 64 * j); }
#pragma unroll
        for (int r = 0; r < 4; ++r) { const int row = row0 + r * NGW; if (row < MTOK) { u32x2* o = (u32x2*)(xb + (size_t)row * 1024) + lane; float s = 0.f;
#pragma unroll
            for (int j = 0; j < 4; ++j) { const f32x4 x = v[r][j]; s += (x[0] * x[0] + x[1] * x[1]) + (x[2] * x[2] + x[3] * x[3]); u32x2 w; w.x = pk2(x[0], x[1]); w.y = pk2(x[2], x[3]); o[64 * j] = w; }
#pragma unroll
            for (int off = 1; off < 64; off <<= 1) s += __shfl_xor(s, off);
            if (lane == 0) ss[row] = s; } }
    }
    { f32x4* z = (f32x4*)(ss + MTOK); const int n4 = 6 * MTOK / 4; for (int i = blockIdx.x * 512 + tid; i < n4; i += gridDim.x * 512) z[i] = (f32x4){0.f, 0.f, 0.f, 0.f}; }
    { float* rope = (float*)(ws + WS_ROPE); const int* pos = (const int*)a.in[1];
      for (int i = blockIdx.x * 512 + tid; i < MTOK * 32; i += gridDim.x * 512) { const int tok = i >> 5, k = i & 31;
          const float inv = 1.0f / exp2f((float)k * 0.41524101186092029f);
          const float ang = (float)pos[tok] * inv;
          const double rr = (double)ang * 0.15915494309189535; const float fr_ = (float)(rr - rint(rr)) * 6.283185307179586f;
          rope[(size_t)tok * 64 + k] = cosf(fr_); rope[(size_t)tok * 64 + 32 + k] = sinf(fr_); } }
}

constexpr int HG_QI = 0, HG_KI = 17408, HG_QH = 34816, HG_KT = 52224, HG_IT = 70656, HG_PP = 89088, HG_ST = 98304, HG_REF = 133120, HG_TOT = 135680, HG_SS = 137728;
static_assert(HG_SS + 512 <= LDS_BYTES, "hgrn lds");
constexpr size_t HGS_QH = 0, HGS_KT = 16384, HGS_IT = 32768, HGS_PP = 49152, HGS_DEC = 57344, HGS_STRIDE = 57856;
static_assert(HGS_STRIDE * 2048 <= (size_t)MTOK * 1024 * 4, "hgrn scratch must fit in d_out");
constexpr size_t R1_SEG_OFF = (size_t)MTOK * 3072 * 2, R1_SEGD_OFF = R1_SEG_OFF + (size_t)256 * 65536;
constexpr int HL_QI = 0, HL_KI = 17408, HL_QH = 60928, HL_KT = 78336, HL_IT = 96768, HL_PP = 115200, HL_REF = 124416, HL_TOT = 126976;
static_assert(HL_TOT + 2048 <= LDS_BYTES - 16, "hgrn local lds");
__device__ __forceinline__ void hgrn_local_items(const Args& a, LAS unsigned char* lds, int item) {
    const int first = item * 8, stride = 1, last = first + 8;
    const int tid = threadIdx.x, wid = tid >> 6, lane = tid & 63, fr = lane & 15, g = lane >> 4;
    const int d = tid & 127, rg = tid >> 7;
    const bf16_t* P = (const bf16_t*)(a.ws + WS_R1);
    LAS float* REF = (LAS float*)(lds + HL_REF); LAS float* TOT = (LAS float*)(lds + HL_TOT);
    bf16_t rq[16], rf[16], ri[16];
    f32x4 S[8];
#pragma unroll
    for (int n = 0; n < 8; ++n) S[n] = (f32x4){0.f, 0.f, 0.f, 0.f};
    float dtot[4] = {1.f, 1.f, 1.f, 1.f};
    { const int bh = first >> 5, ch = first & 31; const bf16_t* pr = P + (size_t)((bh >> 2) * SEQ + ch * 64 + 16 * rg) * 3072 + (bh & 3) * 128 + d;
#pragma unroll
        for (int t = 0; t < 16; ++t) { rq[t] = pr[(size_t)t * 3072]; rf[t] = pr[(size_t)t * 3072 + 512]; ri[t] = pr[(size_t)t * 3072 + 1024]; } }
    const float lbv = sigmoidf_(a.in[9][((first >> 5) & 3) * 128 + d] - a.in[9][512 + ((first >> 5) & 3) * 128 + d]);
    for (int idx = first; idx < last; idx += stride) {
        const int bh = idx >> 5, h = bh & 3;
        unsigned char* scr = (unsigned char*)a.out + (size_t)idx * HGS_STRIDE;
        float qv[16], kv[16], bb[16];
        { float run = 0.f; unsigned iv[8];
#pragma unroll
          for (int t = 0; t < 16; ++t) { const float fp = bf2f(rf[t]); qv[t] = bf2f(rq[t]);
              const float f = lbv + (1.0f - lbv) * sigmoidf_(fp); run += __logf(f); bb[t] = run; kv[t] = 1.0f - f;
              const unsigned iraw = ri[t]; if (t & 1) iv[t >> 1] |= iraw << 16; else iv[t >> 1] = iraw; }
          TOT[rg * 128 + d] = run;
          *(LAS u32x4*)(lds + HL_IT + d * 144 + rg * 32) = (u32x4){iv[0], iv[1], iv[2], iv[3]};
          *(LAS u32x4*)(lds + HL_IT + d * 144 + rg * 32 + 16) = (u32x4){iv[4], iv[5], iv[6], iv[7]}; }
        if (idx + stride < last) { const int nx = idx + stride, nbh = nx >> 5, nch = nx & 31; const bf16_t* pr = P + (size_t)((nbh >> 2) * SEQ + nch * 64 + 16 * rg) * 3072 + (nbh & 3) * 128 + d;
#pragma unroll
            for (int t = 0; t < 16; ++t) { rq[t] = pr[(size_t)t * 3072]; rf[t] = pr[(size_t)t * 3072 + 512]; ri[t] = pr[(size_t)t * 3072 + 1024]; } }
        wg_barrier();
        { float off = 0.f;
#pragma unroll
          for (int r = 0; r < 3; ++r) { const float tv = TOT[r * 128 + d]; off += (r < rg) ? tv : 0.f; }
#pragma unroll
          for (int t = 0; t < 16; ++t) bb[t] += off;
          REF[rg * 128 + d] = bb[8]; if (rg == 3) REF[512 + d] = bb[15]; }
        wg_barrier();
        { const float blast = REF[512 + d]; const float e1 = __expf(bb[8]), ft = __expf(blast - bb[8]);
          float fI[4];
#pragma unroll
          for (int I = 0; I < 4; ++I) fI[I] = __expf(fminf(REF[I * 128 + d] - bb[8], 0.f));
          unsigned kp[8]; float kt0 = 0.f;
#pragma unroll
          for (int t = 0; t < 16; ++t) { const int row = 16 * rg + t; const float eo = __expf(bb[t] - bb[8]); const float qi = qv[t] * eo, ki = kv[t] * __builtin_amdgcn_rcpf(eo);
              *(LAS bf16_t*)(lds + HL_QI + row * 272 + d * 2) = f2bf(qi);
              *(LAS bf16_t*)(lds + HL_QH + row * 272 + d * 2) = f2bf(qi * e1);
#pragma unroll
              for (int I = 0; I < 4; ++I) if (I >= rg) *(LAS bf16_t*)(lds + HL_KI + (8 * I * (I + 1) + row) * 272 + d * 2) = f2bf(ki * fI[I]);
              const float ktv = ki * ft; if (t & 1) kp[t >> 1] = pk2(kt0, ktv); else kt0 = ktv; }
          *(LAS u32x4*)(lds + HL_KT + d * 144 + rg * 32) = (u32x4){kp[0], kp[1], kp[2], kp[3]};
          *(LAS u32x4*)(lds + HL_KT + d * 144 + rg * 32 + 16) = (u32x4){kp[4], kp[5], kp[6], kp[7]}; }
        wg_barrier();
#pragma unroll
        for (int kk = 0; kk < 2; ++kk) { const int tile = wid + 8 * kk, I = tile >> 2, J = tile & 3;
            if (J <= I) { f32x4 c = (f32x4){0.f, 0.f, 0.f, 0.f};
#pragma unroll
                for (int ks = 0; ks < 4; ++ks) c = mfma16(lds_frag(lds, HL_QI + (16 * I + fr) * 272 + ks * 64 + g * 16), lds_frag(lds, HL_KI + (8 * I * (I + 1) + 16 * J + fr) * 272 + ks * 64 + g * 16), c);
#pragma unroll
                for (int j = 0; j < 4; ++j) { float v = c[j]; if (J == I && fr > 4 * g + j) v = 0.f; *(LAS bf16_t*)(lds + HL_PP + (16 * I + 4 * g + j) * 144 + (16 * J + fr) * 2) = f2bf(v); }
            } else {
#pragma unroll
                for (int j = 0; j < 4; ++j) *(LAS bf16_t*)(lds + HL_PP + (16 * I + 4 * g + j) * 144 + (16 * J + fr) * 2) = (bf16_t)0;
            } }
        wg_barrier();
        { float dec[4];
#pragma unroll
          for (int j = 0; j < 4; ++j) { dec[j] = __expf(REF[512 + 16 * wid + 4 * g + j]); dtot[j] *= dec[j]; }
#pragma unroll
          for (int n = 0; n < 8; ++n)
#pragma unroll
              for (int j = 0; j < 4; ++j) S[n][j] *= dec[j];
#pragma unroll
          for (int ks = 0; ks < 2; ++ks) { const bf16x8 av = lds_frag(lds, HL_KT + (16 * wid + fr) * 144 + ks * 64 + g * 16);
#pragma unroll
              for (int n = 0; n < 8; ++n) S[n] = mfma16(av, lds_frag(lds, HL_IT + (16 * n + fr) * 144 + ks * 64 + g * 16), S[n]); } }
#pragma unroll
        for (int k = 0; k < 2; ++k) { const int e = tid + 512 * k;
            *(u32x4*)(scr + HGS_QH + (size_t)e * 16) = *(const LAS u32x4*)(lds + HL_QH + (e >> 4) * 272 + (e & 15) * 16);
            *(u32x4*)(scr + HGS_KT + (size_t)e * 16) = *(const LAS u32x4*)(lds + HL_KT + (e >> 3) * 144 + (e & 7) * 16);
            *(u32x4*)(scr + HGS_IT + (size_t)e * 16) = *(const LAS u32x4*)(lds + HL_IT + (e >> 3) * 144 + (e & 7) * 16); }
        *(u32x4*)(scr + HGS_PP + (size_t)tid * 16) = *(const LAS u32x4*)(lds + HL_PP + (tid >> 3) * 144 + (tid & 7) * 16);
        if (tid < 128) ((float*)(scr + HGS_DEC))[tid] = __expf(REF[512 + tid]);
        wg_barrier();
    }
    { f32x4* so = (f32x4*)(a.ws + WS_R1 + R1_SEG_OFF + (size_t)item * 65536) + (size_t)wid * 512 + lane;
#pragma unroll
      for (int n = 0; n < 8; ++n) so[n * 64] = S[n];
      if (fr == 0) *(f32x4*)((float*)(a.ws + WS_R1 + R1_SEGD_OFF) + (size_t)item * 128 + 16 * wid + 4 * g) = (f32x4){dtot[0], dtot[1], dtot[2], dtot[3]}; }
}
constexpr size_t R1_SEG = (size_t)MTOK * 3072 * 2;
constexpr size_t R1_SEGD = R1_SEG + (size_t)256 * 65536;
static_assert(R1_SEGD + 256 * 512 <= R1_BYTES, "segment scratch");
__device__ __forceinline__ void hgrn_seg_state(const Args& a, LAS unsigned char* lds, int item) {
    const int tid = threadIdx.x, wid = tid >> 6, lane = tid & 63, fr = lane & 15, g = lane >> 4;
    const int bh = item >> 2, seg = item & 3;
    const unsigned char* scr0 = (const unsigned char*)a.out + ((size_t)bh * 32 + seg * 8) * HGS_STRIDE;
    LAS float* DEC = (LAS float*)(lds + HG_REF);
    f32x4 S[8];
#pragma unroll
    for (int n = 0; n < 8; ++n) S[n] = (f32x4){0.f, 0.f, 0.f, 0.f};
    float dtot[4] = {1.f, 1.f, 1.f, 1.f};
    u32x4 rk[2], ri[2]; float rd = 0.f;
#pragma unroll
    for (int k = 0; k < 2; ++k) { const unsigned e = tid + 512 * k; rk[k] = *(const u32x4*)(scr0 + HGS_KT + e * 16); ri[k] = *(const u32x4*)(scr0 + HGS_IT + e * 16); }
    if (tid < 128) rd = ((const float*)(scr0 + HGS_DEC))[tid];
    for (int c = 0; c < 8; ++c) {
#pragma unroll
        for (int k = 0; k < 2; ++k) { const int e = tid + 512 * k;
            *(LAS u32x4*)(lds + HG_KT + (e >> 3) * 144 + (e & 7) * 16) = rk[k];
            *(LAS u32x4*)(lds + HG_IT + (e >> 3) * 144 + (e & 7) * 16) = ri[k]; }
        if (tid < 128) DEC[tid] = rd;
        wg_barrier();
        if (c + 1 < 8) { const unsigned char* sc = scr0 + (size_t)(c + 1) * HGS_STRIDE;
#pragma unroll
            for (int k = 0; k < 2; ++k) { const unsigned e = tid + 512 * k; rk[k] = *(const u32x4*)(sc + HGS_KT + e * 16); ri[k] = *(const u32x4*)(sc + HGS_IT + e * 16); }
            if (tid < 128) rd = ((const float*)(sc + HGS_DEC))[tid]; }
        float dec[4];
#pragma unroll
        for (int j = 0; j < 4; ++j) { dec[j] = DEC[16 * wid + 4 * g + j]; dtot[j] *= dec[j]; }
#pragma unroll
        for (int n = 0; n < 8; ++n)
#pragma unroll
            for (int j = 0; j < 4; ++j) S[n][j] *= dec[j];
#pragma unroll
        for (int ks = 0; ks < 2; ++ks) { const bf16x8 av = lds_frag(lds, HG_KT + (16 * wid + fr) * 144 + ks * 64 + g * 16);
#pragma unroll
            for (int n = 0; n < 8; ++n) S[n] = mfma16(av, lds_frag(lds, HG_IT + (16 * n + fr) * 144 + ks * 64 + g * 16), S[n]); }
        wg_barrier();
    }
    f32x4* so = (f32x4*)(a.ws + WS_R1 + R1_SEG + (size_t)item * 65536) + (size_t)wid * 512 + lane;
#pragma unroll
    for (int n = 0; n < 8; ++n) so[n * 64] = S[n];
    if (fr == 0) *(f32x4*)((float*)(a.ws + WS_R1 + R1_SEGD) + (size_t)item * 128 + 16 * wid + 4 * g) = (f32x4){dtot[0], dtot[1], dtot[2], dtot[3]};
}
__device__ __forceinline__ void hgrn_seq_item(const Args& a, LAS unsigned char* lds, int item) {
    const int tid = threadIdx.x, wid = tid >> 6, lane = tid & 63, fr = lane & 15, g = lane >> 4;
    const int bh = item >> 2, seg = item & 3, ch_lo = seg * 8, ch_hi = ch_lo + 8;
    const int b = bh >> 2, h = bh & 3;
    const bf16_t* P = (const bf16_t*)(a.ws + WS_R1);
    bf16_t* cat = (bf16_t*)(a.ws + WS_CAT);
    const unsigned char* scr0 = (const unsigned char*)a.out + ((size_t)bh * 32 + ch_lo) * HGS_STRIDE;
    LAS float* DEC = (LAS float*)(lds + HG_REF); LAS float* SSQ = (LAS float*)(lds + HG_SS);
    f32x4 S[8];
#pragma unroll
    for (int n = 0; n < 8; ++n) S[n] = (f32x4){0.f, 0.f, 0.f, 0.f};
    for (int sp = 0; sp < seg; ++sp) {
        const f32x4* si = (const f32x4*)(a.ws + WS_R1 + R1_SEG + (size_t)(bh * 4 + sp) * 65536) + (size_t)wid * 512 + lane;
        const f32x4 dd = *(const f32x4*)((const float*)(a.ws + WS_R1 + R1_SEGD) + (size_t)(bh * 4 + sp) * 128 + 16 * wid + 4 * g);
#pragma unroll
        for (int n = 0; n < 8; ++n) S[n] = S[n] * dd + si[n * 64];
    }
#pragma unroll
    for (int n = 0; n < 8; ++n) { u32x2 w; w.x = pk2(S[n][0], S[n][1]); w.y = pk2(S[n][2], S[n][3]); *(LAS u32x2*)(lds + HG_ST + (16 * n + fr) * 272 + (16 * wid + 4 * g) * 2) = w; }
    const int tt_o = wid >> 1, dvh = wid & 1;
    float gn[4];
#pragma unroll
    for (int n = 0; n < 4; ++n) gn[n] = a.in[10][h * 128 + dvh * 64 + 16 * n + fr];
    u32x4 rq[2], rk[2], ri[2], rp; float rd = 0.f;
#pragma unroll
    for (int k = 0; k < 2; ++k) { const unsigned e = tid + 512 * k; rq[k] = *(const u32x4*)(scr0 + HGS_QH + e * 16); rk[k] = *(const u32x4*)(scr0 + HGS_KT + e * 16); ri[k] = *(const u32x4*)(scr0 + HGS_IT + e * 16); }
    rp = *(const u32x4*)(scr0 + HGS_PP + (unsigned)tid * 16); if (tid < 128) rd = ((const float*)(scr0 + HGS_DEC))[tid];
    f32x4 O[4];
#pragma unroll
    for (int n = 0; n < 4; ++n) O[n] = (f32x4){0.f, 0.f, 0.f, 0.f};
    bf16_t gq[4][4];
#pragma unroll
    for (int j = 0; j < 4; ++j)
#pragma unroll
        for (int n = 0; n < 4; ++n) gq[j][n] = 0;
    for (int ch = ch_lo; ch <= ch_hi; ++ch) {
        if (ch > ch_lo) {
            const int tok0 = b * SEQ + (ch - 1) * 64;
#pragma unroll
            for (int n = 0; n < 8; ++n) { u32x2 w; w.x = pk2(S[n][0], S[n][1]); w.y = pk2(S[n][2], S[n][3]); *(LAS u32x2*)(lds + HG_ST + (16 * n + fr) * 272 + (16 * wid + 4 * g) * 2) = w; }
#pragma unroll
            for (int j = 0; j < 4; ++j) { const int t = 16 * tt_o + 4 * g + j; const float rstd = rsqrtf((SSQ[t] + SSQ[64 + t]) * (1.0f / 128.0f) + EPS);
                const size_t tok = (size_t)(tok0 + t);
#pragma unroll
                for (int n = 0; n < 4; ++n) { const int dv = dvh * 64 + 16 * n + fr; const float gval = bf2f(gq[j][n]);
                    cat[tok * 1024 + h * 128 + dv] = f2bf(O[n][j] * rstd * gn[n] * siluf_(gval)); } }
        }
        if (ch == ch_hi) break;
#pragma unroll
        for (int k = 0; k < 2; ++k) { const int e = tid + 512 * k;
            *(LAS u32x4*)(lds + HG_QH + (e >> 4) * 272 + (e & 15) * 16) = rq[k];
            *(LAS u32x4*)(lds + HG_KT + (e >> 3) * 144 + (e & 7) * 16) = rk[k];
            *(LAS u32x4*)(lds + HG_IT + (e >> 3) * 144 + (e & 7) * 16) = ri[k]; }
        *(LAS u32x4*)(lds + HG_PP + (tid >> 3) * 144 + (tid & 7) * 16) = rp;
        if (tid < 128) DEC[tid] = rd;
        wg_barrier();
        if (ch + 1 < ch_hi) { const unsigned char* sc = scr0 + (size_t)(ch + 1 - ch_lo) * HGS_STRIDE;
#pragma unroll
            for (int k = 0; k < 2; ++k) { const unsigned e = tid + 512 * k; rq[k] = *(const u32x4*)(sc + HGS_QH + e * 16); rk[k] = *(const u32x4*)(sc + HGS_KT + e * 16); ri[k] = *(const u32x4*)(sc + HGS_IT + e * 16); }
            rp = *(const u32x4*)(sc + HGS_PP + (unsigned)tid * 16); if (tid < 128) rd = ((const float*)(sc + HGS_DEC))[tid]; }
        { const bf16_t* gp = P + (size_t)(b * SEQ + ch * 64 + 16 * tt_o + 4 * g) * 3072 + 1536 + h * 128 + dvh * 64 + fr;
#pragma unroll
          for (int j = 0; j < 4; ++j)
#pragma unroll
              for (int n = 0; n < 4; ++n) gq[j][n] = gp[(size_t)j * 3072 + 16 * n]; }
#pragma unroll
        for (int n = 0; n < 4; ++n) O[n] = (f32x4){0.f, 0.f, 0.f, 0.f};
#pragma unroll
        for (int ks = 0; ks < 4; ++ks) { const bf16x8 av = lds_frag(lds, HG_QH + (16 * tt_o + fr) * 272 + ks * 64 + g * 16);
#pragma unroll
            for (int n = 0; n < 4; ++n) O[n] = mfma16(av, lds_frag(lds, HG_ST + (dvh * 64 + 16 * n + fr) * 272 + ks * 64 + g * 16), O[n]); }
        for (int ks = 0; ks <= (tt_o >> 1); ++ks) { const bf16x8 av = lds_frag(lds, HG_PP + (16 * tt_o + fr) * 144 + ks * 64 + g * 16);
#pragma unroll
            for (int n = 0; n < 4; ++n) O[n] = mfma16(av, lds_frag(lds, HG_IT + (dvh * 64 + 16 * n + fr) * 144 + ks * 64 + g * 16), O[n]); }
#pragma unroll
        for (int j = 0; j < 4; ++j) { float s = O[0][j] * O[0][j] + O[1][j] * O[1][j] + O[2][j] * O[2][j] + O[3][j] * O[3][j];
            s += __shfl_xor(s, 1); s += __shfl_xor(s, 2); s += __shfl_xor(s, 4); s += __shfl_xor(s, 8);
            if (fr == 0) SSQ[dvh * 64 + 16 * tt_o + 4 * g + j] = s; }
        { float dec[4];
#pragma unroll
          for (int j = 0; j < 4; ++j) dec[j] = DEC[16 * wid + 4 * g + j];
#pragma unroll
          for (int n = 0; n < 8; ++n)
#pragma unroll
              for (int j = 0; j < 4; ++j) S[n][j] *= dec[j];
#pragma unroll
          for (int ks = 0; ks < 2; ++ks) { const bf16x8 av = lds_frag(lds, HG_KT + (16 * wid + fr) * 144 + ks * 64 + g * 16);
#pragma unroll
              for (int n = 0; n < 8; ++n) S[n] = mfma16(av, lds_frag(lds, HG_IT + (16 * n + fr) * 144 + ks * 64 + g * 16), S[n]); } }
        wg_barrier();
    }
    wg_barrier();
}

constexpr int SG_W = 0, SG_V = 34816;
typedef short v4i16_t __attribute__((ext_vector_type(4)));
__device__ __forceinline__ void sgu_items(const Args& a, LAS unsigned char* lds, int first, int stride) {
    const int tid = threadIdx.x, wid = tid >> 6, lane = tid & 63, fr = lane & 15, g = lane >> 4;
    const int gi = first & 3;
    const bf16_t* P = (const bf16_t*)(a.ws + WS_R1);
    bf16_t* cat = (bf16_t*)(a.ws + WS_CAT);
    { const float* W = a.in[13] + (size_t)gi * 16384;
#pragma unroll
      for (int k = 0; k < 4; ++k) { const int e = tid + 512 * k, t = e >> 4, s0 = (e & 15) * 8; const f32x4 w0 = *(const f32x4*)(W + t * 128 + s0), w1 = *(const f32x4*)(W + t * 128 + s0 + 4);
          float v[8] = {w0[0], w0[1], w0[2], w0[3], w1[0], w1[1], w1[2], w1[3]};
#pragma unroll
          for (int j = 0; j < 8; ++j) if (s0 + j > t) v[j] = 0.f;
          *(LAS u32x4*)(lds + SG_W + t * 272 + s0 * 2) = (u32x4){pk2(v[0], v[1]), pk2(v[2], v[3]), pk2(v[4], v[5]), pk2(v[6], v[7])}; } }
    const int cg = tid & 15, srow = tid >> 4;
    float lgv[8], lbv[8];
#pragma unroll
    for (int j = 0; j < 8; ++j) { lgv[j] = a.in[11][gi * 128 + 8 * cg + j]; lbv[j] = a.in[12][gi * 128 + 8 * cg + j]; }
    const int q = fr >> 2, pp = fr & 3;
    const float bs = a.in[14][gi * 128 + 16 * wid + fr];
    u32x4 rv[4];
    if (first < 1024) {
#pragma unroll
        for (int k = 0; k < 4; ++k) rv[k] = *(const u32x4*)(P + (size_t)((first >> 2) * 128 + srow + 32 * k) * 3072 + 2560 + gi * 128 + 8 * cg); }
    for (int it = first; it < 1024; it += stride) {
        const int tok0 = (it >> 2) * 128;
#pragma unroll
        for (int k = 0; k < 4; ++k) { float x[8] = {bflo(rv[k].x), bfhi(rv[k].x), bflo(rv[k].y), bfhi(rv[k].y), bflo(rv[k].z), bfhi(rv[k].z), bflo(rv[k].w), bfhi(rv[k].w)};
            float s1 = 0.f, s2 = 0.f;
#pragma unroll
            for (int j = 0; j < 8; ++j) { s1 += x[j]; s2 += x[j] * x[j]; }
#pragma unroll
            for (int off = 1; off < 16; off <<= 1) { s1 += __shfl_xor(s1, off); s2 += __shfl_xor(s2, off); }
            const float mean = s1 * (1.0f / 128.0f), rstd = rsqrtf(fmaxf(s2 * (1.0f / 128.0f) - mean * mean, 0.f) + EPS);
#pragma unroll
            for (int j = 0; j < 8; ++j) x[j] = (x[j] - mean) * rstd * lgv[j] + lbv[j];
            *(LAS u32x4*)(lds + SG_V + (srow + 32 * k) * 272 + cg * 16) = (u32x4){pk2(x[0], x[1]), pk2(x[2], x[3]), pk2(x[4], x[5]), pk2(x[6], x[7])}; }
        wg_barrier();
        if (it + stride < 1024) {
#pragma unroll
            for (int k = 0; k < 4; ++k) rv[k] = *(const u32x4*)(P + (size_t)(((it + stride) >> 2) * 128 + srow + 32 * k) * 3072 + 2560 + gi * 128 + 8 * cg); }
        u32x2 uu[8];
        { const bf16_t* up = P + (size_t)(tok0 + 16 * wid + fr) * 3072 + 2048 + gi * 128 + 4 * g;
#pragma unroll
          for (int m = 0; m < 8; ++m) uu[m] = *(const u32x2*)(up + 16 * m); }
        f32x4 Z[8];
#pragma unroll
        for (int m = 0; m < 8; ++m) Z[m] = (f32x4){0.f, 0.f, 0.f, 0.f};
        for (int ks = 0; ks <= (wid >> 1); ++ks) { const bf16x8 bw = lds_frag(lds, SG_W + (16 * wid + fr) * 272 + ks * 64 + g * 16);
#pragma unroll
            for (int m = 0; m < 8; ++m) { LAS unsigned char* ap = lds + SG_V + (32 * ks + 8 * g + q) * 272 + (16 * m + 4 * pp) * 2;
                const v4i16_t a0 = __builtin_amdgcn_ds_read_tr16_b64_v4i16((LAS v4i16_t*)ap), a1 = __builtin_amdgcn_ds_read_tr16_b64_v4i16((LAS v4i16_t*)(ap + 4 * 272));
                const bf16x8 av = (bf16x8){a0[0], a0[1], a0[2], a0[3], a1[0], a1[1], a1[2], a1[3]};
                Z[m] = mfma16(av, bw, Z[m]); } }
        { const int t = 16 * wid + fr; const size_t tok = (size_t)(tok0 + t);
          bf16_t* op = cat + tok * 1024 + 512 + gi * 128 + 4 * g;
#pragma unroll
          for (int m = 0; m < 8; ++m) { u32x2 w; w.x = pk2(bflo(uu[m].x) * (Z[m][0] + bs), bfhi(uu[m].x) * (Z[m][1] + bs)); w.y = pk2(bflo(uu[m].y) * (Z[m][2] + bs), bfhi(uu[m].y) * (Z[m][3] + bs)); *(u32x2*)(op + 16 * m) = w; } }
        wg_barrier();
    }
}

__device__ __forceinline__ void conv_items(const Args& a, LAS unsigned char* lds) {
    const int tid = threadIdx.x, wid = tid >> 6, lane = tid & 63, c = tid;
    const bf16_t* H = (const bf16_t*)(a.ws + WS_R1 + R1_HGLU);
    bf16_t* cat = (bf16_t*)(a.ws + WS_CAT);
    LAS float* YS = (LAS float*)lds; LAS float* ST2 = (LAS float*)(lds + 32768);
    float w[31];
#pragma unroll
    for (int j = 0; j < 31; ++j) w[j] = a.in[17][j * 512 + c];
    const float cb = a.in[18][c], lg = a.in[19][c], lb = a.in[20][c];
    bf16_t xr[46];
    if ((int)blockIdx.x < MTOK / 16) { const int tok0 = blockIdx.x * 16, t0 = tok0 & 2047;
#pragma unroll
        for (int i = 0; i < 46; ++i) { const int t = t0 - 30 + i; xr[i] = H[(size_t)(tok0 + (t >= 0 ? i - 30 : 0)) * 512 + c]; } }
    for (int item = blockIdx.x; item < MTOK / 16; item += gridDim.x) {
        const int tok0 = item * 16, t0 = tok0 & 2047;
        float x[46];
#pragma unroll
        for (int i = 0; i < 46; ++i) { const int t = t0 - 30 + i; x[i] = (t >= 0) ? bf2f(xr[i]) : 0.f; }
        if (item + (int)gridDim.x < MTOK / 16) { const int ntok0 = (item + gridDim.x) * 16, nt0 = ntok0 & 2047;
#pragma unroll
            for (int i = 0; i < 46; ++i) { const int t = nt0 - 30 + i; xr[i] = H[(size_t)(ntok0 + (t >= 0 ? i - 30 : 0)) * 512 + c]; } }
        float y[16];
#pragma unroll
        for (int o = 0; o < 16; ++o) { float s = cb;
#pragma unroll
            for (int j = 0; j < 31; ++j) s += w[j] * x[o + j];
            y[o] = s; YS[o * 512 + c] = s; }
        wg_barrier();
#pragma unroll
        for (int k = 0; k < 2; ++k) { const int o = 2 * wid + k; float v[8]; float sm = 0.f;
#pragma unroll
            for (int i = 0; i < 8; ++i) { v[i] = YS[o * 512 + lane + 64 * i]; sm += v[i]; }
#pragma unroll
            for (int off = 1; off < 64; off <<= 1) sm += __shfl_xor(sm, off);
            const float mean = sm * (1.0f / 512.0f); float q = 0.f;
#pragma unroll
            for (int i = 0; i < 8; ++i) q += (v[i] - mean) * (v[i] - mean);
#pragma unroll
            for (int off = 1; off < 64; off <<= 1) q += __shfl_xor(q, off);
            if (lane == 0) { ST2[2 * o] = mean; ST2[2 * o + 1] = rsqrtf(q * (1.0f / 512.0f) + EPS); } }
        wg_barrier();
#pragma unroll
        for (int o = 0; o < 16; ++o) { const float v = (y[o] - ST2[2 * o]) * ST2[2 * o + 1] * lg + lb; cat[(size_t)(tok0 + o) * 1024 + c] = f2bf(siluf_(v)); }
        wg_barrier();
    }
}
__device__ __forceinline__ void krope_items(const Args& a) {
    const bf16_t* pq = (const bf16_t*)(a.ws + WS_R1 + R1_PQKV); bf16_t* Kb = (bf16_t*)(a.ws + WS_R1 + R1_KB); const float* rope = (const float*)(a.ws + WS_ROPE);
    for (int i = blockIdx.x * 512 + threadIdx.x; i < MTOK * 4; i += gridDim.x * 512) { const int tok = i >> 2, k8 = (i & 3) * 8;
        const u32x4 r1 = *(const u32x4*)(pq + (size_t)tok * 768 + 640 + k8), r2 = *(const u32x4*)(pq + (size_t)tok * 768 + 672 + k8);
        const float* rp = rope + (size_t)tok * 64 + k8; const f32x4 c0 = *(const f32x4*)rp, c1 = *(const f32x4*)(rp + 4), s0 = *(const f32x4*)(rp + 32), s1 = *(const f32x4*)(rp + 36);
        const float x1[8] = {bflo(r1.x), bfhi(r1.x), bflo(r1.y), bfhi(r1.y), bflo(r1.z), bfhi(r1.z), bflo(r1.w), bfhi(r1.w)}, x2[8] = {bflo(r2.x), bfhi(r2.x), bflo(r2.y), bfhi(r2.y), bflo(r2.z), bfhi(r2.z), bflo(r2.w), bfhi(r2.w)};
        const float cs[8] = {c0[0], c0[1], c0[2], c0[3], c1[0], c1[1], c1[2], c1[3]}, sn[8] = {s0[0], s0[1], s0[2], s0[3], s1[0], s1[1], s1[2], s1[3]};
        float o1[8], o2[8];
#pragma unroll
        for (int j = 0; j < 8; ++j) { o1[j] = x1[j] * cs[j] - x2[j] * sn[j]; o2[j] = x1[j] * sn[j] + x2[j] * cs[j]; }
        const u32x4 w1 = (u32x4){pk2(o1[0], o1[1]), pk2(o1[2], o1[3]), pk2(o1[4], o1[5]), pk2(o1[6], o1[7])}, w2 = (u32x4){pk2(o2[0], o2[1]), pk2(o2[2], o2[3]), pk2(o2[4], o2[5]), pk2(o2[6], o2[7])};
        const int b = tok >> 11, t = tok & 2047;
#pragma unroll
        for (int h = 0; h < 4; ++h) { bf16_t* kr = Kb + ((size_t)(b * 4 + h) * 2048 + t) * 192 + 128 + k8; *(u32x4*)kr = w1; *(u32x4*)(kr + 32) = w2; } }
}

constexpr int AT_K = 0, AT_V = 67584, AT_KB = 33792, AT_VB = 18432;
__device__ __forceinline__ void attn_items(const Args& a, LAS unsigned char* lds) {
    const int tid = threadIdx.x, wid = __builtin_amdgcn_readfirstlane(tid >> 6), lane = tid & 63, fr = lane & 15, g = lane >> 4;
    const bf16_t* Q = (const bf16_t*)(a.ws + WS_R1 + R1_Q); const bf16_t* Kb = (const bf16_t*)(a.ws + WS_R1 + R1_KB); const bf16_t* Vt = (const bf16_t*)(a.ws + WS_R1 + R1_VT);
    const float* rope = (const float*)(a.ws + WS_ROPE); bf16_t* cat = (bf16_t*)(a.ws + WS_CAT);
    for (int item0 = blockIdx.x; item0 < 256; item0 += gridDim.x) {
        const int item = (gridDim.x == 256) ? ((item0 & 7) * 32 + (item0 >> 3)) : item0;
        const int bh = item >> 2, p = item & 3, b = bh >> 2, h = bh & 3;
        const unsigned char* kbase = (const unsigned char*)(Kb + (size_t)bh * 2048 * 192);
        const unsigned char* vbase = (const unsigned char*)(Vt + (size_t)bh * 2048 * 128);
        for (int half = 0; half < 2; ++half) {
            const int qb = half ? 7 - p : p;
            const int q0 = qb * 256 + wid * 32;
            u32x4 kreg[3], vreg[2];
#pragma unroll
            for (int k = 0; k < 3; ++k) kreg[k] = *(const u32x4*)(kbase + (unsigned)(tid * 16 + 8192 * k));
#pragma unroll
            for (int k = 0; k < 2; ++k) { const int e = tid + 512 * k; vreg[k] = *(const u32x4*)(vbase + (unsigned)(e * 16)); }
            bf16x8 qf[2][6];
#pragma unroll
            for (int qt = 0; qt < 2; ++qt) { const size_t tok = (size_t)b * SEQ + q0 + 16 * qt + fr; const bf16_t* qr = Q + tok * 768 + h * 192 + 8 * g;
#pragma unroll
                for (int ks = 0; ks < 6; ++ks) qf[qt][ks] = *(const bf16x8*)(qr + 32 * ks);
                const float* rp = rope + tok * 64 + 8 * g; const f32x4 c0 = *(const f32x4*)rp, c1 = *(const f32x4*)(rp + 4), s0 = *(const f32x4*)(rp + 32), s1 = *(const f32x4*)(rp + 36);
                const float cs[8] = {c0[0], c0[1], c0[2], c0[3], c1[0], c1[1], c1[2], c1[3]}, sn[8] = {s0[0], s0[1], s0[2], s0[3], s1[0], s1[1], s1[2], s1[3]};
                bf16x8 r1, r2;
#pragma unroll
                for (int j = 0; j < 8; ++j) { const float x1 = bf2f((bf16_t)qf[qt][4][j]), x2 = bf2f((bf16_t)qf[qt][5][j]);
                    r1[j] = (short)f2bf(x1 * cs[j] - x2 * sn[j]); r2[j] = (short)f2bf(x1 * sn[j] + x2 * cs[j]); }
                qf[qt][4] = r1; qf[qt][5] = r2; }
            f32x4 O[8][2];
#pragma unroll
            for (int mt = 0; mt < 8; ++mt) { O[mt][0] = (f32x4){0.f, 0.f, 0.f, 0.f}; O[mt][1] = (f32x4){0.f, 0.f, 0.f, 0.f}; }
            float mrow[2] = {-1e30f, -1e30f}, lrow[2] = {0.f, 0.f};
            const int ntile = qb * 4 + 4;
#pragma unroll
            for (int k = 0; k < 3; ++k) { const int e = tid + 512 * k; const int r_ = e / 24, c_ = e % 24; *(LAS u32x4*)(lds + AT_K + r_ * 528 + ((c_ ^ (((r_ + 4) >> 3) & 1)) * 16)) = kreg[k]; }
#pragma unroll
            for (int k = 0; k < 2; ++k) { const int e = tid + 512 * k; *(LAS u32x4*)(lds + AT_V + (e >> 4) * 288 + (e & 15) * 16) = vreg[k]; }
            wg_barrier();
            for (int kt = 0; kt < ntile; ++kt) {
                const int buf = kt & 1; const bool more = kt + 1 < ntile;
                LAS unsigned char* ks_ = lds + AT_K + buf * AT_KB; LAS unsigned char* vs_ = lds + AT_V + buf * AT_VB; const int gx = (g ^ (((fr + 4) >> 3) & 1)) * 16;
                if (more) {
#pragma unroll
                    for (int k = 0; k < 3; ++k) kreg[k] = *(const u32x4*)(kbase + (size_t)(kt + 1) * 24576 + (unsigned)(tid * 16 + 8192 * k));
#pragma unroll
                    for (int k = 0; k < 2; ++k) { const int e = tid + 512 * k; vreg[k] = *(const u32x4*)(vbase + (size_t)(kt + 1) * 16384 + (unsigned)(e * 16)); }
                }
#pragma unroll
                for (int u = 0; u < 2; ++u) {
                    if (kt * 64 + 32 * u <= q0) {
                        f32x4 st[2][2];
#pragma unroll
                        for (int kk = 0; kk < 2; ++kk) { st[kk][0] = (f32x4){0.f, 0.f, 0.f, 0.f}; st[kk][1] = (f32x4){0.f, 0.f, 0.f, 0.f};
#pragma unroll
                            for (int ks = 0; ks < 6; ++ks) { const bf16x8 kf = lds_frag(ks_, (16 * (2 * u + kk) + fr) * 528 + ks * 64 + gx);
                                st[kk][0] = mfma16(kf, qf[0][ks], st[kk][0]); st[kk][1] = mfma16(kf, qf[1][ks], st[kk][1]); } }
                        if (kt * 64 + 32 * u == q0) {
#pragma unroll
                            for (int kk = 0; kk < 2; ++kk)
#pragma unroll
                                for (int qt = 0; qt < 2; ++qt)
#pragma unroll
                                    for (int j = 0; j < 4; ++j) if (16 * kk + 4 * g + j > 16 * qt + fr) st[kk][qt][j] = -INFINITY;
                        }
                        bf16x8 pb[2];
#pragma unroll
                        for (int qt = 0; qt < 2; ++qt) { float mx = -INFINITY;
#pragma unroll
                            for (int kk = 0; kk < 2; ++kk)
#pragma unroll
                                for (int j = 0; j < 4; ++j) mx = fmaxf(mx, st[kk][qt][j]);
                            mx = xor16_max(mx); mx = xor32_max(mx);
                            const bool need = mx > mrow[qt] + 8.0f;
                            if (__builtin_amdgcn_ballot_w64(need) != 0ull) { const float mnew = need ? mx : mrow[qt], alpha = __builtin_amdgcn_exp2f(mrow[qt] - mnew); mrow[qt] = mnew; lrow[qt] *= alpha;
#pragma unroll
                                for (int mt = 0; mt < 8; ++mt) O[mt][qt] *= alpha; }
                            const float mref = mrow[qt]; float ls = 0.f;
#pragma unroll
                            for (int kk = 0; kk < 2; ++kk)
#pragma unroll
                                for (int j = 0; j < 4; ++j) { const float pv = __builtin_amdgcn_exp2f(st[kk][qt][j] - mref); st[kk][qt][j] = pv; ls += pv; }
                            lrow[qt] += ls;
                            pb[qt] = __builtin_bit_cast(bf16x8, (u32x4){pk2(st[0][qt][0], st[0][qt][1]), pk2(st[0][qt][2], st[0][qt][3]), pk2(st[1][qt][0], st[1][qt][1]), pk2(st[1][qt][2], st[1][qt][3])}); }
#pragma unroll
                        for (int mt = 0; mt < 8; ++mt) { LAS unsigned char* vp_ = vs_ + (32 * u + 4 * g + (fr >> 2)) * 288 + (16 * mt + 4 * (fr & 3)) * 2;
                            const v4i16_t a0 = __builtin_amdgcn_ds_read_tr16_b64_v4i16((LAS v4i16_t*)vp_), a1 = __builtin_amdgcn_ds_read_tr16_b64_v4i16((LAS v4i16_t*)(vp_ + 16 * 288));
                            const bf16x8 vf = (bf16x8){a0[0], a0[1], a0[2], a0[3], a1[0], a1[1], a1[2], a1[3]};
                            O[mt][0] = mfma16(vf, pb[0], O[mt][0]); O[mt][1] = mfma16(vf, pb[1], O[mt][1]); }
                    }
                    if (more) {
                        if (u == 0) {
#pragma unroll
                            for (int k = 0; k < 3; ++k) { const int e = tid + 512 * k; const int r_ = e / 24, c_ = e % 24; *(LAS u32x4*)(lds + AT_K + (buf ^ 1) * AT_KB + r_ * 528 + ((c_ ^ (((r_ + 4) >> 3) & 1)) * 16)) = kreg[k]; }
                        } else {
#pragma unroll
                            for (int k = 0; k < 2; ++k) { const int e = tid + 512 * k; *(LAS u32x4*)(lds + AT_V + (buf ^ 1) * AT_VB + (e >> 4) * 288 + (e & 15) * 16) = vreg[k]; }
                        }
                    }
                }
                wg_barrier();
            }
#pragma unroll
            for (int qt = 0; qt < 2; ++qt) { float l = lrow[qt]; l += __shfl_xor(l, 16); l += __shfl_xor(l, 32); const float inv = 1.0f / l;
                bf16_t* orow = cat + ((size_t)b * SEQ + q0 + 16 * qt + fr) * 1024 + 512 + h * 128 + 4 * g;
#pragma unroll
                for (int mt = 0; mt < 8; ++mt) { u32x2 w; w.x = pk2(O[mt][qt][0] * inv, O[mt][qt][1] * inv); w.y = pk2(O[mt][qt][2] * inv, O[mt][qt][3] * inv); *(u32x2*)(orow + 16 * mt) = w; } }
        }
    }
}

__device__ __forceinline__ void final_norm(const Args& a) {
    const float* ss4 = (const float*)(a.ws + WS_SS) + 4 * MTOK; const bf16_t* xb = (const bf16_t*)(a.ws + WS_XB);
    const int stride = gridDim.x * 512;
    for (int i0 = blockIdx.x * 512 + threadIdx.x; i0 < MTOK * 128; i0 += 4 * stride) {
        u32x4 r[4]; float sq[4];
#pragma unroll
        for (int k = 0; k < 4; ++k) { const int i = (i0 + k * stride < MTOK * 128) ? i0 + k * stride : i0; r[k] = *(const u32x4*)(xb + (size_t)(i >> 7) * 1024 + (i & 127) * 8); sq[k] = ss4[i >> 7]; }
#pragma unroll
        for (int k = 0; k < 4; ++k) { const int i = i0 + k * stride; if (i < MTOK * 128) { const int row = i >> 7, c8 = (i & 127) * 8;
            const float rstd = rsqrtf(sq[k] * (1.0f / 1024.0f) + EPS);
            const f32x4 w0 = *(const f32x4*)(a.in[25] + c8), w1 = *(const f32x4*)(a.in[25] + c8 + 4);
            f32x4 o0 = (f32x4){bflo(r[k].x), bfhi(r[k].x), bflo(r[k].y), bfhi(r[k].y)}, o1 = (f32x4){bflo(r[k].z), bfhi(r[k].z), bflo(r[k].w), bfhi(r[k].w)};
            o0 = o0 * rstd * w0; o1 = o1 * rstd * w1;
            __builtin_nontemporal_store(o0, (f32x4*)(a.out + (size_t)row * 1024 + c8)); __builtin_nontemporal_store(o1, (f32x4*)(a.out + (size_t)row * 1024 + c8 + 4)); } }
    }
}

constexpr int NPHASE = 13;
__global__ void __launch_bounds__(512, 2) mega(Args a) {
    extern __shared__ __attribute__((aligned(16))) unsigned char shm[];
    LAS unsigned char* lds = (LAS unsigned char*)shm;
    cg::grid_group grid = cg::this_grid();
    volatile LAS unsigned* xst = (volatile LAS unsigned*)(lds + LDS_BYTES - 16);
    if (threadIdx.x == 0) { xst[0] = 0u; xst[1] = 0u; }
    __syncthreads();
    const XcdBarrier xbar = xcd_barrier_post((unsigned*)(a.ws + WS_BAR), xst);
    unsigned char* ws = a.ws;
    float* ss = (float*)(ws + WS_SS);
    bf16_t* xb = (bf16_t*)(ws + WS_XB); bf16_t* cat = (bf16_t*)(ws + WS_CAT); bf16_t* r1 = (bf16_t*)(ws + WS_R1);
#define PHASE_BEGIN(n) if (a.ph_lo <= (n) && (n) < a.ph_hi) {
#define PHASE_END(n) if ((n) + 1 < a.ph_hi) { xcd_barrier(xbar); } }
#ifndef REP_MASK
#define REP_MASK 0
#endif
#define REP_EN(n) (((REP_MASK) >> (n)) & 1)
    if (a.ph_hi > 1000) grid.sync();
    PHASE_BEGIN(0) phase_prologue(a, lds); if (REP_EN(0)) { xcd_barrier(xbar); phase_prologue(a, lds); } PHASE_END(0)
    PHASE_BEGIN(1) { EpiInEven E; E.O = r1; E.ss = ss; E.ssrc = ss; run_gemm(lds, xb, 1024, (const bf16_t*)(ws + WS_W_IN0), 3072, 1024, E); if (REP_EN(1)) { xcd_barrier(xbar); run_gemm(lds, xb, 1024, (const bf16_t*)(ws + WS_W_IN0), 3072, 1024, E); } } PHASE_END(1)
    PHASE_BEGIN(2) { const int G = gridDim.x, bx = blockIdx.x;
                  for (int it = bx; it < 256; it += G) hgrn_local_items(a, lds, it);
                  if (bx < (G & ~3)) sgu_items(a, lds, bx, G & ~3);
                  xcd_barrier(xbar);
                  for (int it = bx; it < 256; it += G) hgrn_seq_item(a, lds, it);
                  if (REP_EN(2)) { xcd_barrier(xbar); for (int it = bx; it < 256; it += G) hgrn_local_items(a, lds, it); }
                  if (REP_EN(14)) { xcd_barrier(xbar); for (int it = bx; it < 256; it += G) if ((it & 3) != 3) hgrn_seg_state(a, lds, it); if (bx < (G & ~3)) sgu_items(a, lds, bx, G & ~3); }
                  if (REP_EN(13)) { xcd_barrier(xbar); for (int it = bx; it < 256; it += G) hgrn_seq_item(a, lds, it); } } PHASE_END(2)
    PHASE_BEGIN(3) { EpiResid E; E.xb = xb; E.ss = ss + MTOK; run_gemm(lds, cat, 1024, (const bf16_t*)(ws + WS_W_OUT0), 1024, 1024, E); } PHASE_END(3)
    PHASE_BEGIN(4) { EpiSwiglu E; E.O = r1; E.ss = ss + MTOK; E.ssrc = ss + MTOK; run_gemm(lds, xb, 1024, (const bf16_t*)(ws + WS_W_GU0), 5632, 1024, E); if (REP_EN(4)) { xcd_barrier(xbar); run_gemm(lds, xb, 1024, (const bf16_t*)(ws + WS_W_GU0), 5632, 1024, E); } } PHASE_END(4)
    if (REP_MASK & 0xe0000) { if (a.ph_lo <= 4 && 4 < a.ph_hi) { EpiNull E; E.sink = (float*)(ws + WS_BAR + 8192);
        if (REP_EN(17)) run_gemm(lds, xb, 1024, (const bf16_t*)(ws + WS_W_IN0), 3072, 1024, E);
        if (REP_EN(18)) run_gemm(lds, r1, FF, (const bf16_t*)(ws + WS_W_D0), 1024, FF, E);
        if (REP_EN(19)) run_gemm(lds, cat, 1024, (const bf16_t*)(ws + WS_W_OUT0), 1024, 1024, E);
        xcd_barrier(xbar); } }
    PHASE_BEGIN(5) { EpiResid E; E.xb = xb; E.ss = ss + 2 * MTOK; run_gemm(lds, r1, FF, (const bf16_t*)(ws + WS_W_D0), 1024, FF, E); } PHASE_END(5)
    PHASE_BEGIN(6) { EpiInOdd E; E.hglu = (bf16_t*)(ws + WS_R1 + R1_HGLU); E.pqkv = (bf16_t*)(ws + WS_R1 + R1_PQKV); E.ss = ss + 2 * MTOK; E.ssrc = ss + 2 * MTOK; E.ssq = ss + 5 * MTOK; E.sskv = ss + 6 * MTOK;
                  E.thr = 3; E.off0 = 0; E.off1 = 1;
                  run_gemm(lds, xb, 1024, (const bf16_t*)(ws + WS_W_IN1), 1536, 1024, E); } PHASE_END(6)
    PHASE_BEGIN(7) { const int G = gridDim.x, bx = blockIdx.x;
                  { EpiInOdd E; E.hglu = (bf16_t*)(ws + WS_R1 + R1_HGLU); E.pqkv = (bf16_t*)(ws + WS_R1 + R1_PQKV); E.ss = ss + 2 * MTOK; E.ssrc = ss + 2 * MTOK; E.ssq = ss + 5 * MTOK; E.sskv = ss + 6 * MTOK;
                    E.thr = 1; E.off0 = 3; E.off1 = 3;
                    run_gemm(lds, xb, 1024, (const bf16_t*)(ws + WS_W_IN1) + (size_t)1536 * 1024, 256, 1024, E); }
                  { EpiUq E; E.Q = (bf16_t*)(ws + WS_R1 + R1_Q); E.ssq = ss + 5 * MTOK; E.ssrc = ss + 5 * MTOK;
                    if (G == 256) { ListOrder S; S.nM = 128; S.nN = 3; if (bx < 128) { S.first = bx; S.cnt = 1; } else { S.first = 128 + (bx - 128) * 2; S.cnt = 2; }
                        run_gemm_s(lds, (const bf16_t*)(ws + WS_R1 + R1_PQKV), 768, (const bf16_t*)(ws + WS_W_UQ), 768, 384, E, S); }
                    else run_gemm(lds, (const bf16_t*)(ws + WS_R1 + R1_PQKV), 768, (const bf16_t*)(ws + WS_W_UQ), 768, 384, E); }
                  { EpiUkv E; E.Kb = (bf16_t*)(ws + WS_R1 + R1_KB); E.Vt = (bf16_t*)(ws + WS_R1 + R1_VT); E.sskv = ss + 6 * MTOK; E.ssrc = ss + 6 * MTOK;
                    if (G == 256) { ListOrder S; S.nM = 128; S.nN = 4; if (bx < 128) { S.first = bx; S.cnt = 1; } else { S.first = 128 + (bx - 128) * 3; S.cnt = 3; }
                        run_gemm_s(lds, (const bf16_t*)(ws + WS_R1 + R1_PQKV) + 384, 768, (const bf16_t*)(ws + WS_W_UKV), 1024, 256, E, S); }
                    else run_gemm(lds, (const bf16_t*)(ws + WS_R1 + R1_PQKV) + 384, 768, (const bf16_t*)(ws + WS_W_UKV), 1024, 256, E); }
                  krope_items(a); } PHASE_END(7)
    PHASE_BEGIN(8) attn_items(a, lds); conv_items(a, lds); PHASE_END(8)
    PHASE_BEGIN(9) { EpiResid E; E.xb = xb; E.ss = ss + 3 * MTOK; run_gemm(lds, cat, 1024, (const bf16_t*)(ws + WS_W_OUT1), 1024, 1024, E); } PHASE_END(9)
    PHASE_BEGIN(10) { EpiSwiglu E; E.O = r1; E.ss = ss + 3 * MTOK; E.ssrc = ss + 3 * MTOK; run_gemm(lds, xb, 1024, (const bf16_t*)(ws + WS_W_GU1), 5632, 1024, E); } PHASE_END(10)
    PHASE_BEGIN(11) { EpiResid E; E.xb = xb; E.ss = ss + 4 * MTOK; run_gemm(lds, r1, FF, (const bf16_t*)(ws + WS_W_D1), 1024, FF, E); } PHASE_END(11)
    PHASE_BEGIN(12) final_norm(a); PHASE_END(12)
}

#ifndef MK_ONE_LAUNCH
#define MK_ONE_LAUNCH 1
#endif
extern "C" void kernel_launch(void* const* d_in, const int* in_sizes, int n_in, void* d_out, int out_size, void* d_ws, size_t ws_size, hipStream_t stream) {
    static int grid = 0;
    if (grid == 0) {
        if (n_in != 26 || out_size != MTOK * DM || ws_size < WS_END) { fprintf(stderr, "kernel_launch: unexpected shapes (n_in %d, out %d, ws %zu < %zu)\n", n_in, out_size, ws_size, (size_t)WS_END); grid = -1; return; }
        int dev = 0, cus = 0, per_cu = 0;
        hipGetDevice(&dev); hipDeviceGetAttribute(&cus, hipDeviceAttributeMultiprocessorCount, dev);
        if (hipFuncSetAttribute((const void*)mega, hipFuncAttributeMaxDynamicSharedMemorySize, LDS_BYTES) != hipSuccess) { fprintf(stderr, "kernel_launch: hipFuncSetAttribute failed\n"); grid = -1; return; }
        if (hipOccupancyMaxActiveBlocksPerMultiprocessor(&per_cu, (const void*)mega, 512, LDS_BYTES) != hipSuccess || per_cu < 1) { fprintf(stderr, "kernel_launch: occupancy query says %d\n", per_cu); per_cu = 1; }
        (void)hipGetLastError();
        grid = cus * 1;
    }
    if (grid < 0) return;
    if (hipMemsetAsync((char*)d_ws + WS_BAR, 0, XCD_BAR_WORDS * 4, stream) != hipSuccess) { fprintf(stderr, "kernel_launch: memset failed\n"); return; }
    Args a{};
    for (int i = 0; i < 26; ++i) a.in[i] = (const float*)d_in[i];
    a.out = (float*)d_out; a.ws = (unsigned char*)d_ws;
#if MK_ONE_LAUNCH
    a.ph_lo = 0; a.ph_hi = NPHASE;
    void* args[] = {&a};
    hipError_t e = hipLaunchCooperativeKernel((const void*)mega, dim3(grid), dim3(512), args, LDS_BYTES, stream);
    if (e != hipSuccess) fprintf(stderr, "cooperative launch failed: %s (grid %d)\n", hipGetErrorString(e), grid);
#else
    for (int ph = 0; ph < NPHASE; ++ph) { a.ph_lo = ph; a.ph_hi = ph + 1; hipLaunchKernelGGL(mega, dim3(grid), dim3(512), LDS_BYTES, stream, a); }
#endif
}
```

```cpp
#include <hip/hip_runtime.h>
#include <hip/hip_cooperative_groups.h>
#include <cstdio>
#include <cstdint>
namespace cg = cooperative_groups;
namespace pg8 {
#define PG8_LAS __attribute__((address_space(3)))
typedef unsigned short bf16_t;
typedef short bf16x8 __attribute__((ext_vector_type(8)));
typedef float f32x4 __attribute__((ext_vector_type(4)));
typedef unsigned u32x4 __attribute__((ext_vector_type(4)));
constexpr int BM = 256, BK = 64, HALF = 128, HTB = HALF * BK * 2  , STAGE_BYTES = 8 * HTB, NXCD = 8, WGM = 8;

__host__ __device__ __forceinline__ int lds_byte(int r, int c) { const int st = (r >> 4) * 2 + (c >> 5), rr = r & 15, cc = c & 31, ob = rr * 64 + cc * 2; return st * 1024 + (ob ^ (((ob >> 9) & 1) << 5)); }
__host__ __device__ __forceinline__ void stage_rc(int b, int& R, int& C) { const int st = b / 1024, sb = b % 1024, swz = sb ^ (((sb >> 9) & 1) << 5); R = (st >> 1) * 16 + swz / 64; C = (st & 1) * 32 + (swz % 64) / 2; }
__host__ __device__ __forceinline__ int perm32(int rho) { const int n = rho >> 4, i = rho & 15; return 8 * (i >> 2) + 4 * n + (i & 3); }

struct Unit { int pm, pn, idx; };
struct Gemm { const bf16_t* A; const bf16_t* Bt; int M, N, K, lda; };

struct StaticOrder {
    int nM, nN, nwg, G, c;
    __host__ __device__ void init(int M, int N, int G_, int c_) { nM = M / BM; nN = N / BM; nwg = nM * nN; G = G_; c = c_; }
    __host__ __device__ bool next(int i, Unit& u) const {
        const long L = (long)i * G + c; if (L >= nwg) return false;
        int wgid = (int)L; { const int q = nwg / NXCD, r = nwg % NXCD, xcd = wgid % NXCD, off = wgid / NXCD; wgid = (xcd < r ? xcd * (q + 1) : r * (q + 1) + (xcd - r) * q) + off; }
        const int nig = WGM * nN, gid = wgid / nig, fm = gid * WGM, gsz = (nM - fm) < WGM ? (nM - fm) : WGM;
        u.pm = fm + ((wgid % nig) % gsz); u.pn = (wgid % nig) / gsz; u.idx = i; return true;
    }
    __device__ __forceinline__ void a_ready(const Unit&) const {}
    __device__ __forceinline__ void done(const Unit&) const {}
};

__device__ __forceinline__ unsigned cvt_pk_bf16(float lo, float hi) { unsigned r; asm volatile("v_cvt_pk_bf16_f32 %0, %1, %2" : "=v"(r) : "v"(lo), "v"(hi)); return r; }
template <class Epi, class Sched, bool ALIGN_EPI = false, bool SP2 = false>
__device__ __forceinline__ void gemm_phase(PG8_LAS unsigned char* lds, const Gemm g, const Sched& S, const Epi& E) {
    const int tid = threadIdx.x, wid = __builtin_amdgcn_readfirstlane(tid >> 6), lane = tid & 63, wr = wid >> 2, wc = wid & 3, fr = lane & 15, fq = lane >> 4;
    const int K = g.K, nt = K / BK;
    unsigned voffA[2], voffB[2];
#pragma unroll
    for (int i = 0; i < 2; ++i) { int R, C; stage_rc(tid * 16 + i * 8192, R, C); const int Rb = Epi::PERM ? ((R & ~31) + perm32(R & 31)) : R;
        voffA[i] = (unsigned)(R * g.lda + C) * 2u; voffB[i] = (unsigned)(Rb * K + C) * 2u; }
    const size_t kstep = (size_t)(BK * 2);
    const size_t hstep = (size_t)HALF * K * 2;
    const size_t tstep = 2 * hstep; const size_t hstepA = (size_t)HALF * g.lda * 2; const size_t tstepA = 2 * hstepA;
    const unsigned ldsw = (unsigned)wid * 1024u;
    const int aoff = lds_byte(wr * 64 + fr, fq * 8), boff = lds_byte(wc * 32 + fr, fq * 8);
#define PG8_SA(b, h) (((b) * 2 + (h)) * HTB)
#define PG8_SB(b, h) ((4 + (b) * 2 + (h)) * HTB)
#define PG8_STAGE(bufoff, gbase, voff) do { _Pragma("unroll") for (int _i = 0; _i < 2; ++_i) \
        __builtin_amdgcn_global_load_lds((const unsigned*)((const char*)(gbase) + (voff)[_i]), (PG8_LAS unsigned*)(lds + (bufoff) + ldsw + _i * 8192), 16, 0, 0); } while (0)
#define PG8_LDA(dst, b, h) do { _Pragma("unroll") for (int m = 0; m < 4; ++m) _Pragma("unroll") for (int k = 0; k < 2; ++k) dst[m][k] = *(const PG8_LAS bf16x8*)(lds + PG8_SA(b, h) + aoff + m * 2048 + k * 1024); } while (0)
#define PG8_LDB(dst, b, h) do { _Pragma("unroll") for (int n = 0; n < 2; ++n) _Pragma("unroll") for (int k = 0; k < 2; ++k) dst[n][k] = *(const PG8_LAS bf16x8*)(lds + PG8_SB(b, h) + boff + n * 2048 + k * 1024); } while (0)
#define PG8_MMA(ai, bj, At, Bt) do { __builtin_amdgcn_s_setprio(1); _Pragma("unroll") for (int m = 0; m < 4; ++m) _Pragma("unroll") for (int n = 0; n < 2; ++n) _Pragma("unroll") for (int k = 0; k < 2; ++k) \
        acc[ai][bj][m][n] = __builtin_amdgcn_mfma_f32_16x16x32_bf16(Bt[n][k], At[m][k], acc[ai][bj][m][n], 0, 0, 0); __builtin_amdgcn_s_setprio(0); } while (0)
#define PG8_WAIT_V(n) asm volatile("s_waitcnt vmcnt(" #n ")" ::: "memory")
#define PG8_WAIT_L(n) asm volatile("s_waitcnt lgkmcnt(" #n ")" ::: "memory")
#define PG8_BAR __builtin_amdgcn_s_barrier()
#define PG8_SCHED __builtin_amdgcn_sched_barrier(0)
    Unit cur, nxt; int ui = 0;
    if (!S.next(0, cur)) return;
    f32x4 acc[2][2][4][2];
#pragma unroll
    for (int a = 0; a < 2; ++a)
#pragma unroll
        for (int b = 0; b < 2; ++b)
#pragma unroll
            for (int m = 0; m < 4; ++m)
#pragma unroll
                for (int n = 0; n < 2; ++n) acc[a][b][m][n] = (f32x4){0.f, 0.f, 0.f, 0.f};
    bf16x8 At[4][2], B0[2][2], B1[2][2];
    const char* cA = (const char*)g.A + (size_t)cur.pm * tstepA; const char* cB = (const char*)g.Bt + (size_t)cur.pn * tstep;
    S.a_ready(cur);
    if constexpr (SP2) {
        PG8_STAGE(PG8_SB(0, 0), cB, voffB); PG8_STAGE(PG8_SB(0, 1), cB + hstep, voffB); PG8_STAGE(PG8_SA(0, 0), cA, voffA); PG8_STAGE(PG8_SA(0, 1), cA + hstepA, voffA);
        if constexpr (Epi::RSTD_N > 0) E.pre(S);
        if (wr == 1) PG8_BAR;
        PG8_WAIT_V(2); PG8_BAR;
        PG8_STAGE(PG8_SB(1, 0), cB + kstep, voffB); PG8_STAGE(PG8_SA(1, 0), cA + kstep, voffA); PG8_STAGE(PG8_SB(1, 1), cB + hstep + kstep, voffB);
        PG8_WAIT_V(6); PG8_BAR;
    } else {
        PG8_STAGE(PG8_SB(0, 0), cB, voffB); PG8_STAGE(PG8_SA(0, 0), cA, voffA); PG8_STAGE(PG8_SB(0, 1), cB + hstep, voffB); PG8_STAGE(PG8_SA(0, 1), cA + hstepA, voffA);
        if (wr == 1) PG8_BAR;
        PG8_WAIT_V(4); PG8_BAR;
        PG8_STAGE(PG8_SB(1, 0), cB + kstep, voffB); PG8_STAGE(PG8_SA(1, 0), cA + kstep, voffA); PG8_STAGE(PG8_SB(1, 1), cB + hstep + kstep, voffB);
        PG8_WAIT_V(6); PG8_BAR;
    }
    for (;;) {
        const bool has_next = S.next(ui + 1, nxt);
        const char* nA = has_next ? (const char*)g.A + (size_t)nxt.pm * tstepA : cA; const char* nB = has_next ? (const char*)g.Bt + (size_t)nxt.pn * tstep : cB;
#pragma unroll 1
        for (int t = 0; t < nt; t += 2) {
            const bool last = (t == nt - 2);
            const char* a1 = cA + (size_t)(t + 1) * kstep;
            const char* a2 = last ? nA : cA + (size_t)(t + 2) * kstep; const char* b2 = last ? nB : cB + (size_t)(t + 2) * kstep;
            const char* a3 = a2 + kstep; const char* b3 = b2 + kstep;
            if (last && has_next) S.a_ready(nxt);
            if constexpr (SP2) {
            PG8_LDB(B0, 0, 0); PG8_LDB(B1, 0, 1); PG8_SCHED; PG8_LDA(At, 0, 0); PG8_STAGE(PG8_SA(1, 1), a1 + hstepA, voffA);
            PG8_WAIT_V(8); PG8_WAIT_L(0); PG8_BAR; PG8_MMA(0, 0, At, B0); PG8_MMA(0, 1, At, B1); PG8_BAR; PG8_SCHED;
            PG8_LDA(At, 0, 1); PG8_STAGE(PG8_SB(0, 0), b2, voffB); PG8_STAGE(PG8_SB(0, 1), b2 + hstep, voffB); PG8_STAGE(PG8_SA(0, 0), a2, voffA);
            PG8_WAIT_V(8); PG8_WAIT_L(0); PG8_BAR; PG8_MMA(1, 0, At, B0); PG8_MMA(1, 1, At, B1); PG8_BAR; PG8_SCHED;
            PG8_LDB(B0, 1, 0); PG8_LDB(B1, 1, 1); PG8_SCHED; PG8_LDA(At, 1, 0); PG8_STAGE(PG8_SA(0, 1), a2 + hstepA, voffA);
            PG8_WAIT_V(8); PG8_WAIT_L(0); PG8_BAR; PG8_MMA(0, 0, At, B0); PG8_MMA(0, 1, At, B1); PG8_BAR; PG8_SCHED;
            PG8_LDA(At, 1, 1); PG8_STAGE(PG8_SB(1, 0), b3, voffB); PG8_STAGE(PG8_SB(1, 1), b3 + hstep, voffB); PG8_STAGE(PG8_SA(1, 0), a3, voffA);
            PG8_WAIT_V(8); PG8_WAIT_L(0); PG8_BAR; PG8_MMA(1, 0, At, B0); PG8_MMA(1, 1, At, B1); PG8_BAR; PG8_SCHED;
            } else {
            PG8_LDB(B0, 0, 0); PG8_SCHED; PG8_LDA(At, 0, 0); PG8_STAGE(PG8_SA(1, 1), a1 + hstepA, voffA);
            PG8_WAIT_L(8); PG8_BAR; PG8_WAIT_L(0); PG8_MMA(0, 0, At, B0); PG8_BAR; PG8_SCHED;
            PG8_LDB(B1, 0, 1); PG8_STAGE(PG8_SB(0, 0), b2, voffB);
            PG8_BAR; PG8_WAIT_L(0); PG8_MMA(0, 1, At, B1); PG8_BAR;
            PG8_LDA(At, 0, 1); PG8_STAGE(PG8_SA(0, 0), a2, voffA);
            PG8_BAR; PG8_WAIT_L(0); PG8_MMA(1, 0, At, B0); PG8_BAR; PG8_SCHED;
            PG8_STAGE(PG8_SB(0, 1), b2 + hstep, voffB);
            PG8_WAIT_V(6); PG8_BAR; PG8_MMA(1, 1, At, B1); PG8_BAR;
            PG8_LDB(B0, 1, 0); PG8_SCHED; PG8_LDA(At, 1, 0); PG8_STAGE(PG8_SA(0, 1), a2 + hstepA, voffA);
            PG8_WAIT_L(8); PG8_BAR; PG8_WAIT_L(0); PG8_MMA(0, 0, At, B0); PG8_BAR; PG8_SCHED;
            PG8_LDB(B1, 1, 1); PG8_STAGE(PG8_SB(1, 0), b3, voffB);
            PG8_BAR; PG8_WAIT_L(0); PG8_MMA(0, 1, At, B1); PG8_BAR;
            PG8_LDA(At, 1, 1); PG8_STAGE(PG8_SA(1, 0), a3, voffA);
            PG8_BAR; PG8_WAIT_L(0); PG8_MMA(1, 0, At, B0); PG8_BAR; PG8_SCHED;
            PG8_STAGE(PG8_SB(1, 1), b3 + hstep, voffB);
            PG8_WAIT_V(6); PG8_BAR; PG8_MMA(1, 1, At, B1); PG8_BAR;
            }
        }
        if constexpr (ALIGN_EPI) { if (wr == 0) PG8_BAR; }
        if constexpr (!Epi::AFTER_DRAIN) { E(acc, cur, wr, wc, fr, fq); S.done(cur); }
        if (!has_next) break;
#pragma unroll
        for (int a = 0; a < 2; ++a)
#pragma unroll
            for (int b = 0; b < 2; ++b)
#pragma unroll
                for (int m = 0; m < 4; ++m)
#pragma unroll
                    for (int n = 0; n < 2; ++n) acc[a][b][m][n] = (f32x4){0.f, 0.f, 0.f, 0.f};
        cur = nxt; cA = nA; cB = nB; ++ui;
        if constexpr (ALIGN_EPI) { if (wr == 1) PG8_BAR; }
    }
    PG8_WAIT_V(0);
    if constexpr (!ALIGN_EPI) { if (wr == 0) PG8_BAR; }
    PG8_BAR;
    if constexpr (Epi::AFTER_DRAIN) { E.fused(acc, cur, wr, wc, fr, fq, lds, wid, lane); S.done(cur); }
#undef PG8_SA
#undef PG8_SB
#undef PG8_STAGE
#undef PG8_LDA
#undef PG8_LDB
#undef PG8_MMA
#undef PG8_WAIT_V
#undef PG8_WAIT_L
#undef PG8_BAR
#undef PG8_SCHED
}
}

using pg8::bf16_t; using pg8::bf16x8; using pg8::f32x4; using pg8::u32x4;
#define LAS __attribute__((address_space(3)))
typedef unsigned u32x2 __attribute__((ext_vector_type(2)));

constexpr int MTOK = 32768, DM = 1024, SEQ = 2048, NBATCH = 16, FF = 2816;
constexpr float EPS = 1e-6f;
constexpr int LDS_BYTES = 147456;

constexpr size_t WS_W_IN0  = 0;
constexpr size_t WS_W_OUT0 = WS_W_IN0  + (size_t)3072 * 1024 * 2;
constexpr size_t WS_W_GU0  = WS_W_OUT0 + (size_t)1024 * 1024 * 2;
constexpr size_t WS_W_D0   = WS_W_GU0  + (size_t)5632 * 1024 * 2;
constexpr size_t WS_W_IN1  = WS_W_D0   + (size_t)1024 * 2816 * 2;
constexpr size_t WS_W_OUT1 = WS_W_IN1  + (size_t)1792 * 1024 * 2;
constexpr size_t WS_W_GU1  = WS_W_OUT1 + (size_t)1024 * 1024 * 2;
constexpr size_t WS_W_D1   = WS_W_GU1  + (size_t)5632 * 1024 * 2;
constexpr size_t WS_W_UQ   = WS_W_D1   + (size_t)1024 * 2816 * 2;
constexpr size_t WS_W_UKV  = WS_W_UQ   + (size_t)768 * 384 * 2;
constexpr size_t WS_SS     = WS_W_UKV  + (size_t)1024 * 256 * 2;
constexpr size_t WS_ROPE   = WS_SS     + (size_t)7 * MTOK * 4;
constexpr size_t WS_XB     = WS_ROPE   + (size_t)MTOK * 64 * 4;
constexpr size_t WS_CAT    = WS_XB     + (size_t)MTOK * 1024 * 2;
constexpr size_t WS_R1     = WS_CAT    + (size_t)MTOK * 1024 * 2;
constexpr size_t R1_BYTES  = (size_t)220 * 1024 * 1024;
constexpr size_t WS_BAR    = WS_R1 + R1_BYTES;
constexpr size_t WS_END    = WS_BAR + 16384;
constexpr size_t R1_HGLU = 0;
constexpr size_t R1_PQKV = R1_HGLU + (size_t)MTOK * 512 * 2;
constexpr size_t R1_Q    = R1_PQKV + (size_t)MTOK * 768 * 2;
constexpr size_t R1_KB   = R1_Q    + (size_t)MTOK * 768 * 2;
constexpr size_t R1_VT   = R1_KB   + (size_t)MTOK * 4 * 192 * 2;
static_assert(R1_VT + (size_t)MTOK * 512 * 2 <= R1_BYTES, "R1 too small");
static_assert((size_t)MTOK * 3072 * 2 <= R1_BYTES, "R1 too small for p_even");

struct Args { const float* in[26]; float* out; unsigned char* ws; int ph_lo, ph_hi; };

__device__ __forceinline__ float bf2f(bf16_t b) { return __uint_as_float((unsigned)b << 16); }
__device__ __forceinline__ float bflo(unsigned u) { return __uint_as_float(u << 16); }
__device__ __forceinline__ float bfhi(unsigned u) { return __uint_as_float(u & 0xffff0000u); }
__device__ __forceinline__ unsigned pk2(float lo, float hi) { return pg8::cvt_pk_bf16(lo, hi); }
__device__ __forceinline__ bf16_t f2bf(float f) { return (bf16_t)(pk2(f, 0.f) & 0xffffu); }
__device__ __forceinline__ float sigmoidf_(float x) { return __builtin_amdgcn_rcpf(1.0f + __expf(-x)); }
__device__ __forceinline__ float siluf_(float x) { return x * sigmoidf_(x); }
__device__ __forceinline__ float gelu_tanh(float x) { const float z = 1.5957691216057308f * (x + 0.044715f * x * x * x); return x * sigmoidf_(z); }
__device__ __forceinline__ void wg_barrier() { __syncthreads(); }
typedef unsigned u32x2s __attribute__((ext_vector_type(2)));
__device__ __forceinline__ float xor32_max(float x) { const u32x2s r = __builtin_amdgcn_permlane32_swap(__float_as_uint(x), __float_as_uint(x), false, false); return __builtin_fmaxf(__uint_as_float(r.x), __uint_as_float(r.y)); }
__device__ __forceinline__ float xor16_max(float x) { const u32x2s r = __builtin_amdgcn_permlane16_swap(__float_as_uint(x), __float_as_uint(x), false, false); return __builtin_fmaxf(__uint_as_float(r.x), __uint_as_float(r.y)); }
__device__ __forceinline__ f32x4 mfma16(bf16x8 a, bf16x8 b, f32x4 c) { return __builtin_amdgcn_mfma_f32_16x16x32_bf16(a, b, c, 0, 0, 0); }
__device__ __forceinline__ bf16x8 lds_frag(LAS unsigned char* base, int byte_off) { return *(const LAS bf16x8*)(base + byte_off); }

struct EpiInEven {
    static constexpr bool PERM = true, AFTER_DRAIN = false; static constexpr int RSTD_N = 1024; LAS float* rt; const float* ssrc;
    template <class Sched> __device__ __forceinline__ void pre(const Sched& S) const { pg8::Unit u; for (int i = 0; i < 15 && S.next(i, u); ++i) if (threadIdx.x < 256) rt[i * 256 + threadIdx.x] = rsqrtf(ssrc[u.pm * 256 + threadIdx.x] * (1.0f / (float)RSTD_N) + EPS); }
    bf16_t* O; const float* ss;
    __device__ __forceinline__ void operator()(const f32x4 (&acc)[2][2][4][2], const pg8::Unit& u, int wr, int wc, int fr, int fq) const {
        const int row0 = u.pm * 256 + wr * 64 + fr, col0 = u.pn * 256 + wc * 32 + 8 * fq; const bool act = u.pn >= 8;
#pragma unroll
        for (int ai = 0; ai < 2; ++ai)
#pragma unroll
            for (int m = 0; m < 4; ++m) { const int row = row0 + ai * 128 + m * 16; const float rstd = rt[u.idx * 256 + (row - u.pm * 256)];
#pragma unroll
                for (int bj = 0; bj < 2; ++bj) { f32x4 v0 = acc[ai][bj][m][0] * rstd, v1 = acc[ai][bj][m][1] * rstd;
                    if (act) {
#pragma unroll
                        for (int j = 0; j < 4; ++j) { v0[j] = gelu_tanh(v0[j]); v1[j] = gelu_tanh(v1[j]); } }
                    u32x4 w; w.x = pk2(v0[0], v0[1]); w.y = pk2(v0[2], v0[3]); w.z = pk2(v1[0], v1[1]); w.w = pk2(v1[2], v1[3]);
                    __builtin_nontemporal_store(w, (u32x4*)(O + (size_t)row * 3072 + col0 + bj * 128)); } }
    }
};
struct EpiResid {
    static constexpr bool PERM = true, AFTER_DRAIN = false; static constexpr int RSTD_N = 0;
    bf16_t* xb; float* ss;
    __device__ __forceinline__ void operator()(const f32x4 (&acc)[2][2][4][2], const pg8::Unit& u, int wr, int wc, int fr, int fq) const {
        const int row0 = u.pm * 256 + wr * 64 + fr, col0 = u.pn * 256 + wc * 32 + 8 * fq;
#pragma unroll
        for (int ai = 0; ai < 2; ++ai) {
            u32x4 r[4][2];
#pragma unroll
            for (int m = 0; m < 4; ++m)
#pragma unroll
                for (int bj = 0; bj < 2; ++bj) r[m][bj] = *(const u32x4*)(xb + (size_t)(row0 + ai * 128 + m * 16) * 1024 + col0 + bj * 128);
#pragma unroll
            for (int m = 0; m < 4; ++m) { const int row = row0 + ai * 128 + m * 16; bf16_t* xp = xb + (size_t)row * 1024 + col0; float s = 0.f;
#pragma unroll
                for (int bj = 0; bj < 2; ++bj) { const u32x4 q = r[m][bj];
                    u32x4 w; w.x = pk2(bflo(q.x) + acc[ai][bj][m][0][0], bfhi(q.x) + acc[ai][bj][m][0][1]); w.y = pk2(bflo(q.y) + acc[ai][bj][m][0][2], bfhi(q.y) + acc[ai][bj][m][0][3]);
                    w.z = pk2(bflo(q.z) + acc[ai][bj][m][1][0], bfhi(q.z) + acc[ai][bj][m][1][1]); w.w = pk2(bflo(q.w) + acc[ai][bj][m][1][2], bfhi(q.w) + acc[ai][bj][m][1][3]);
                    __builtin_nontemporal_store(w, (u32x4*)(xp + bj * 128));
                    s += (bflo(w.x) * bflo(w.x) + bfhi(w.x) * bfhi(w.x)) + (bflo(w.y) * bflo(w.y) + bfhi(w.y) * bfhi(w.y)) + (bflo(w.z) * bflo(w.z) + bfhi(w.z) * bfhi(w.z)) + (bflo(w.w) * bflo(w.w) + bfhi(w.w) * bfhi(w.w)); }
                s += __shfl_xor(s, 16); s += __shfl_xor(s, 32);
                if (fq == 0) unsafeAtomicAdd(ss + row, s); }
        }
    }
};
struct EpiSwiglu {
    static constexpr bool PERM = true, AFTER_DRAIN = false; static constexpr int RSTD_N = 1024; LAS float* rt; const float* ssrc;
    template <class Sched> __device__ __forceinline__ void pre(const Sched& S) const { pg8::Unit u; for (int i = 0; i < 15 && S.next(i, u); ++i) if (threadIdx.x < 256) rt[i * 256 + threadIdx.x] = rsqrtf(ssrc[u.pm * 256 + threadIdx.x] * (1.0f / (float)RSTD_N) + EPS); }
    bf16_t* O; const float* ss;
    __device__ __forceinline__ void operator()(const f32x4 (&acc)[2][2][4][2], const pg8::Unit& u, int wr, int wc, int fr, int fq) const {
        const int row0 = u.pm * 256 + wr * 64 + fr, col0 = u.pn * 128 + wc * 32 + 8 * fq;
#pragma unroll
        for (int ai = 0; ai < 2; ++ai)
#pragma unroll
            for (int m = 0; m < 4; ++m) { const int row = row0 + ai * 128 + m * 16; const float rstd = rt[u.idx * 256 + (row - u.pm * 256)];
                float h[8];
#pragma unroll
                for (int n = 0; n < 2; ++n)
#pragma unroll
                    for (int j = 0; j < 4; ++j) { const float gv = acc[ai][0][m][n][j] * rstd, uv = acc[ai][1][m][n][j] * rstd; h[n * 4 + j] = siluf_(gv) * uv; }
                u32x4 w; w.x = pk2(h[0], h[1]); w.y = pk2(h[2], h[3]); w.z = pk2(h[4], h[5]); w.w = pk2(h[6], h[7]);
                __builtin_nontemporal_store(w, (u32x4*)(O + (size_t)row * FF + col0)); }
    }
};
struct EpiInOdd {
    static constexpr bool PERM = true, AFTER_DRAIN = false; static constexpr int RSTD_N = 1024; LAS float* rt; const float* ssrc;
    template <class Sched> __device__ __forceinline__ void pre(const Sched& S) const { pg8::Unit u; for (int i = 0; i < 15 && S.next(i, u); ++i) if (threadIdx.x < 256) rt[i * 256 + threadIdx.x] = rsqrtf(ssrc[u.pm * 256 + threadIdx.x] * (1.0f / (float)RSTD_N) + EPS); }
    bf16_t* hglu; bf16_t* pqkv; const float* ss; float* ssq; float* sskv; int thr, off0, off1;
    __device__ __forceinline__ void operator()(const f32x4 (&acc)[2][2][4][2], const pg8::Unit& u, int wr, int wc, int fr, int fq) const {
        const int row0 = u.pm * 256 + wr * 64 + fr; const int lpn = u.pn < thr ? u.pn + off0 : u.pn + off1;
#pragma unroll
        for (int ai = 0; ai < 2; ++ai)
#pragma unroll
            for (int m = 0; m < 4; ++m) { const int row = row0 + ai * 128 + m * 16; const float rstd = rt[u.idx * 256 + (row - u.pm * 256)];
                if (lpn < 4) {
                    float h[8];
#pragma unroll
                    for (int n = 0; n < 2; ++n)
#pragma unroll
                        for (int j = 0; j < 4; ++j) { const float av = acc[ai][0][m][n][j] * rstd, gv = acc[ai][1][m][n][j] * rstd; h[n * 4 + j] = av * sigmoidf_(gv); }
                    u32x4 w; w.x = pk2(h[0], h[1]); w.y = pk2(h[2], h[3]); w.z = pk2(h[4], h[5]); w.w = pk2(h[6], h[7]);
                    __builtin_nontemporal_store(w, (u32x4*)(hglu + (size_t)row * 512 + lpn * 128 + wc * 32 + 8 * fq));
                } else {
                    const int t = lpn - 4;
#pragma unroll
                    for (int bj = 0; bj < 2; ++bj) { const f32x4 v0 = acc[ai][bj][m][0] * rstd, v1 = acc[ai][bj][m][1] * rstd;
                        u32x4 w; w.x = pk2(v0[0], v0[1]); w.y = pk2(v0[2], v0[3]); w.z = pk2(v1[0], v1[1]); w.w = pk2(v1[2], v1[3]);
                        __builtin_nontemporal_store(w, (u32x4*)(pqkv + (size_t)row * 768 + t * 256 + bj * 128 + wc * 32 + 8 * fq));
                        const int which = t * 2 + bj;
                        if (which < 5) { float s = (v0[0] * v0[0] + v0[1] * v0[1]) + (v0[2] * v0[2] + v0[3] * v0[3]) + (v1[0] * v1[0] + v1[1] * v1[1]) + (v1[2] * v1[2] + v1[3] * v1[3]);
                            s += __shfl_xor(s, 16); s += __shfl_xor(s, 32);
                            if (fq == 0) unsafeAtomicAdd((which < 3 ? ssq : sskv) + row, s); } } } }
    }
};
constexpr float QSCALE = 0.07216878364870322f * 1.4426950408889634f;
struct EpiUq {
    static constexpr bool PERM = true, AFTER_DRAIN = false; static constexpr int RSTD_N = 384; LAS float* rt; const float* ssrc;
    template <class Sched> __device__ __forceinline__ void pre(const Sched& S) const { pg8::Unit u; for (int i = 0; i < 15 && S.next(i, u); ++i) if (threadIdx.x < 256) rt[i * 256 + threadIdx.x] = rsqrtf(ssrc[u.pm * 256 + threadIdx.x] * (1.0f / (float)RSTD_N) + EPS); }
    bf16_t* Q; const float* ssq;
    __device__ __forceinline__ void operator()(const f32x4 (&acc)[2][2][4][2], const pg8::Unit& u, int wr, int wc, int fr, int fq) const {
        const int row0 = u.pm * 256 + wr * 64 + fr, col0 = u.pn * 256 + wc * 32 + 8 * fq;
#pragma unroll
        for (int ai = 0; ai < 2; ++ai)
#pragma unroll
            for (int m = 0; m < 4; ++m) { const int row = row0 + ai * 128 + m * 16; const float rstd = rt[u.idx * 256 + (row - u.pm * 256)] * QSCALE;
#pragma unroll
                for (int bj = 0; bj < 2; ++bj) { const f32x4 v0 = acc[ai][bj][m][0] * rstd, v1 = acc[ai][bj][m][1] * rstd;
                    u32x4 w; w.x = pk2(v0[0], v0[1]); w.y = pk2(v0[2], v0[3]); w.z = pk2(v1[0], v1[1]); w.w = pk2(v1[2], v1[3]);
                    __builtin_nontemporal_store(w, (u32x4*)(Q + (size_t)row * 768 + col0 + bj * 128)); } }
    }
};
struct EpiUkv {
    static constexpr bool PERM = true, AFTER_DRAIN = false; static constexpr int RSTD_N = 256; LAS float* rt; const float* ssrc;
    template <class Sched> __device__ __forceinline__ void pre(const Sched& S) const { pg8::Unit u; for (int i = 0; i < 15 && S.next(i, u); ++i) if (threadIdx.x < 256) rt[i * 256 + threadIdx.x] = rsqrtf(ssrc[u.pm * 256 + threadIdx.x] * (1.0f / (float)RSTD_N) + EPS); }
    bf16_t* Kb; bf16_t* Vt; const float* sskv;
    __device__ __forceinline__ void operator()(const f32x4 (&acc)[2][2][4][2], const pg8::Unit& u, int wr, int wc, int fr, int fq) const {
        const int row0 = u.pm * 256 + wr * 64 + fr, h = u.pn;
#pragma unroll
        for (int ai = 0; ai < 2; ++ai)
#pragma unroll
            for (int m = 0; m < 4; ++m) { const int row = row0 + ai * 128 + m * 16; const float rstd = rt[u.idx * 256 + (row - u.pm * 256)];
                const int b = row >> 11, t = row & 2047; const size_t bh = (size_t)(b * 4 + h);
                { const f32x4 v0 = acc[ai][0][m][0] * rstd, v1 = acc[ai][0][m][1] * rstd;
                  u32x4 w; w.x = pk2(v0[0], v0[1]); w.y = pk2(v0[2], v0[3]); w.z = pk2(v1[0], v1[1]); w.w = pk2(v1[2], v1[3]);
                  __builtin_nontemporal_store(w, (u32x4*)(Kb + (bh * 2048 + t) * 192 + wc * 32 + 8 * fq)); }
{ const f32x4 v0 = acc[ai][1][m][0] * rstd, v1 = acc[ai][1][m][1] * rstd;
                  u32x4 w; w.x = pk2(v0[0], v0[1]); w.y = pk2(v0[2], v0[3]); w.z = pk2(v1[0], v1[1]); w.w = pk2(v1[2], v1[3]);
                  __builtin_nontemporal_store(w, (u32x4*)(Vt + (bh * 2048 + t) * 128 + wc * 32 + 8 * fq)); } }
    }
};

struct EpiNull {
    static constexpr bool PERM = true, AFTER_DRAIN = false; static constexpr int RSTD_N = 0;
    float* sink;
    __device__ __forceinline__ void operator()(const f32x4 (&acc)[2][2][4][2], const pg8::Unit& u, int wr, int wc, int fr, int fq) const {
        f32x4 s = (f32x4){0.f, 0.f, 0.f, 0.f};
#pragma unroll
        for (int ai = 0; ai < 2; ++ai)
#pragma unroll
            for (int bj = 0; bj < 2; ++bj)
#pragma unroll
                for (int m = 0; m < 4; ++m) { s += acc[ai][bj][m][0]; s += acc[ai][bj][m][1]; }
        if (s[0] + s[1] + s[2] + s[3] == 12345.678f) sink[0] = 1.f;
    }
};
struct ListOrder {
    int nM, nN, first, cnt;
    __device__ bool next(int i, pg8::Unit& u) const {
        if (i >= cnt) return false;
        const int wgid = first + i, nig = pg8::WGM * nN, gid = wgid / nig, fm = gid * pg8::WGM, gsz = (nM - fm) < pg8::WGM ? (nM - fm) : pg8::WGM;
        u.pm = fm + ((wgid % nig) % gsz); u.pn = (wgid % nig) / gsz; u.idx = i; return true;
    }
    __device__ __forceinline__ void a_ready(const pg8::Unit&) const {}
    __device__ __forceinline__ void done(const pg8::Unit&) const {}
};
template <class Epi, class Sched>
__device__ __forceinline__ void run_gemm_s(LAS unsigned char* lds, const bf16_t* A, int lda, const bf16_t* Bt, int N, int K, Epi E, const Sched& S) {
    pg8::Gemm g; g.A = A; g.Bt = Bt; g.M = MTOK; g.N = N; g.K = K; g.lda = lda;
    if constexpr (Epi::RSTD_N > 0) E.rt = (LAS float*)(lds + pg8::STAGE_BYTES);
    pg8::gemm_phase<Epi, Sched, true, true>(lds, g, S, E);
}
template <class Epi>
__device__ __forceinline__ void run_gemm(LAS unsigned char* lds, const bf16_t* A, int lda, const bf16_t* Bt, int N, int K, Epi E, int stagger = 0) {
    pg8::Gemm g; g.A = A; g.Bt = Bt; g.M = MTOK; g.N = N; g.K = K; g.lda = lda;
    pg8::StaticOrder S; S.init(MTOK, N, (int)gridDim.x, (int)blockIdx.x);
    if constexpr (Epi::RSTD_N > 0) E.rt = (LAS float*)(lds + pg8::STAGE_BYTES);
    pg8::gemm_phase<Epi, pg8::StaticOrder, true, true>(lds, g, S, E);
}
#define XB_TMO      128
#define XB_XCNT(j)  (256  + 64 * (j))
#define XB_XSUB(j)  (1280 + 64 * (j))
#define XB_XGEN(j)  (2304 + 64 * (j))
#define XB_TOP      3328
#define XB_TOPGEN   3392
#define XCD_BAR_WORDS 3456
#define XB_SPIN_CAP (1u << 18)

__device__ __forceinline__ unsigned xb_ld(unsigned* p)              { return __hip_atomic_load(p, __ATOMIC_RELAXED, __HIP_MEMORY_SCOPE_AGENT); }
__device__ __forceinline__ unsigned xb_add(unsigned* p, unsigned v) { return __hip_atomic_fetch_add(p, v, __ATOMIC_RELAXED, __HIP_MEMORY_SCOPE_AGENT); }
__device__ __forceinline__ unsigned xb_xcc_id() { return (unsigned)__builtin_amdgcn_s_getreg((3 << 11) | 20) & 0xFu; }
#define XB_SPIN(cond, bar) do { unsigned _sp = 0; while (cond) { __builtin_amdgcn_s_sleep(1); \
    if ((++_sp & 255u) == 0u) { if (xb_ld(&(bar)[XB_TMO])) break; if (_sp > XB_SPIN_CAP) { atomicAdd(&(bar)[XB_TMO], 1u); break; } } } } while (0)

struct XcdBarrier {
    unsigned* bar; unsigned x;
    volatile LAS unsigned* st;
};

__device__ __forceinline__ XcdBarrier xcd_barrier_post(unsigned* bar, volatile LAS unsigned* st) {
    XcdBarrier b; b.bar = bar; b.x = xb_xcc_id(); b.st = st;
    if (threadIdx.x == 0) (void)xb_add(&bar[XB_XCNT(b.x)], 1u);
    return b;
}
__device__ __forceinline__ void xcd_barrier_complete(unsigned* bar, unsigned x, unsigned& nloc, unsigned& nx) {
    const unsigned G = gridDim.x * gridDim.y * gridDim.z;
    unsigned sum, cnt, mine, sp = 0u;
    for (;;) {
        sum = 0u; cnt = 0u; mine = 0u;
#pragma unroll
        for (unsigned j = 0; j < 16; ++j) { const unsigned c = xb_ld(&bar[XB_XCNT(j)]); sum += c; cnt += (c > 0u) ? 1u : 0u; mine = (j == x) ? c : mine; }
        if (sum == G) break;
        __builtin_amdgcn_s_sleep(1);
        if ((++sp & 255u) == 0u) { if (xb_ld(&bar[XB_TMO])) break; if (sp > XB_SPIN_CAP) { atomicAdd(&bar[XB_TMO], 1u); break; } }
    }
    nloc = mine > 0u ? mine : 1u; nx = cnt > 0u ? cnt : 1u;
}

__device__ __forceinline__ void xcd_barrier(const XcdBarrier& b) {
    asm volatile("s_waitcnt vmcnt(0)" ::: "memory");
    __syncthreads();
    if (threadIdx.x == 0) {
        unsigned* bar = b.bar;
        __builtin_amdgcn_s_waitcnt(0);
        unsigned nloc = b.st[0], nx = b.st[1];
        if (nloc == 0u) { xcd_barrier_complete(bar, b.x, nloc, nx); b.st[0] = nloc; b.st[1] = nx; }
        const unsigned old = xb_add(&bar[XB_XSUB(b.x)], 1u);
        const unsigned gen = old / nloc;
        if (old + 1u == (gen + 1u) * nloc) {
            __builtin_amdgcn_fence(__ATOMIC_RELEASE, "agent");
            asm volatile("s_waitcnt vmcnt(0)" ::: "memory");
            const unsigned og = xb_add(&bar[XB_TOP], 1u);
            const unsigned tg = og / nx;
            if (og + 1u == (tg + 1u) * nx) xb_add(&bar[XB_TOPGEN], 1u);
            else XB_SPIN(xb_ld(&bar[XB_TOPGEN]) == tg, bar);
            __builtin_amdgcn_fence(__ATOMIC_ACQUIRE, "agent");
            xb_add(&bar[XB_XGEN(b.x)], 1u);
            asm volatile("s_waitcnt vmcnt(0)" ::: "memory");
        } else {
            XB_SPIN(xb_ld(&bar[XB_XGEN(b.x)]) == gen, bar);
            __builtin_amdgcn_fence(__ATOMIC_ACQUIRE, "agent");
            asm volatile("s_waitcnt vmcnt(0)" ::: "memory");
        }
    }
    __syncthreads();
}

__device__ __forceinline__ void tr_item(const float* W, int ld, int col0, int k0, const float* gain, bf16_t* WT, int K, int nrow0, LAS float* scr, int lane) {
    const float keep = col0 >= 0 ? 1.0f : 0.0f; const int colc = col0 >= 0 ? col0 : 0; const int c = lane & 7;
    f32x4 g0 = (f32x4){keep, keep, keep, keep}, g1 = g0;
    if (gain) { g0 = *(const f32x4*)(gain + k0 + 8 * c) * keep; g1 = *(const f32x4*)(gain + k0 + 8 * c + 4) * keep; }
#pragma unroll 8
    for (int i = 0; i < 32; ++i) { const int kk = 2 * i + (lane >> 5); scr[kk * 33 + (lane & 31)] = W[(size_t)(k0 + kk) * ld + colc + (lane & 31)]; }
    asm volatile("s_waitcnt lgkmcnt(0)" ::: "memory");
#pragma unroll
    for (int j = 0; j < 4; ++j) { const int n = (lane >> 3) + 8 * j; const LAS float* s = scr + (8 * c) * 33 + n;
        u32x4 o; o.x = pk2(s[0 * 33] * g0[0], s[1 * 33] * g0[1]); o.y = pk2(s[2 * 33] * g0[2], s[3 * 33] * g0[3]); o.z = pk2(s[4 * 33] * g1[0], s[5 * 33] * g1[1]); o.w = pk2(s[6 * 33] * g1[2], s[7 * 33] * g1[3]);
        *(u32x4*)(WT + (size_t)(nrow0 + n) * K + k0 + 8 * c) = o; }
    asm volatile("s_waitcnt lgkmcnt(0)" ::: "memory");
}
__device__ __forceinline__ void convert_weights(const Args& a, LAS unsigned char* lds, int lo, int hi, int gw, int NGW) {
    const int tid = threadIdx.x, wid = tid >> 6, lane = tid & 63;
    unsigned char* ws = a.ws;
    LAS float* scr = (LAS float*)(lds + wid * 8704);
    constexpr int I0 = 1536, I1 = 512, I2 = 2816, I3 = 1408, I4 = 896, I5 = 512, I6 = 2816, I7 = 1408, I8 = 144, I9 = 128;
    for (int it = lo + gw; it < hi; it += NGW) {
        int r = it;
        if (r < I0) { const int kb = r / 96, nb = r % 96; tr_item(a.in[7], 3072, nb * 32, kb * 64, a.in[2], (bf16_t*)(ws + WS_W_IN0), 1024, nb * 32, scr, lane); continue; } r -= I0;
        if (r < I1) { const int kb = r / 32, nb = r % 32; tr_item(a.in[8], 1024, nb * 32, kb * 64, nullptr, (bf16_t*)(ws + WS_W_OUT0), 1024, nb * 32, scr, lane); continue; } r -= I1;
        if (r < I2) { const int kb = r / 176, nb = r % 176, n0 = nb * 32, tile = n0 >> 8, rr = n0 & 255;
            tr_item(rr < 128 ? a.in[4] : a.in[5], FF, tile * 128 + (rr & 127), kb * 64, a.in[3], (bf16_t*)(ws + WS_W_GU0), 1024, n0, scr, lane); continue; } r -= I2;
        if (r < I3) { const int kb = r / 32, nb = r % 32; tr_item(a.in[6], 1024, nb * 32, kb * 64, nullptr, (bf16_t*)(ws + WS_W_D0), FF, nb * 32, scr, lane); continue; } r -= I3;
        if (r < I4) { const int kb = r / 56, nb = r % 56, n0 = nb * 32; int col;
            { const int pt = n0 >> 8, rr = n0 & 255, lt = pt < 3 ? pt : (pt < 6 ? pt + 1 : 3), ln = lt * 256 + rr;
              if (lt < 4) col = rr < 128 ? lt * 128 + rr : 512 + lt * 128 + (rr - 128); else col = ln < 1728 ? ln : -1; }
            tr_item(a.in[15], 1728, col, kb * 64, a.in[2] + 1024, (bf16_t*)(ws + WS_W_IN1), 1024, n0, scr, lane); continue; } r -= I4;
        if (r < I5) { const int kb = r / 32, nb = r % 32; tr_item(a.in[16], 1024, nb * 32, kb * 64, nullptr, (bf16_t*)(ws + WS_W_OUT1), 1024, nb * 32, scr, lane); continue; } r -= I5;
        if (r < I6) { const int kb = r / 176, nb = r % 176, n0 = nb * 32, tile = n0 >> 8, rr = n0 & 255;
            tr_item((rr < 128 ? a.in[4] : a.in[5]) + (size_t)1024 * FF, FF, tile * 128 + (rr & 127), kb * 64, a.in[3] + 1024, (bf16_t*)(ws + WS_W_GU1), 1024, n0, scr, lane); continue; } r -= I6;
        if (r < I7) { const int kb = r / 32, nb = r % 32; tr_item(a.in[6] + (size_t)FF * 1024, 1024, nb * 32, kb * 64, nullptr, (bf16_t*)(ws + WS_W_D1), FF, nb * 32, scr, lane); continue; } r -= I7;
        if (r < I8) { const int kb = r / 24, nb = r % 24; tr_item(a.in[22], 768, nb * 32, kb * 64, a.in[21], (bf16_t*)(ws + WS_W_UQ), 384, nb * 32, scr, lane); continue; } r -= I8;
        { const int kb = r / 32, nb = r % 32; tr_item(a.in[24], 1024, nb * 32, kb * 64, a.in[23], (bf16_t*)(ws + WS_W_UKV), 256, nb * 32, scr, lane); }
    }
}
constexpr int WCONV_FIRST = 1536, WCONV_ALL = 1536 + 512 + 2816 + 1408 + 896 + 512 + 2816 + 1408 + 144 + 128;
__device__ __forceinline__ void phase_prologue(const Args& a, LAS unsigned char* lds) {
    const int tid = threadIdx.x, wid = tid >> 6, lane = tid & 63;
    const int gw = blockIdx.x * 8 + wid, NGW = gridDim.x * 8;
    unsigned char* ws = a.ws;
    convert_weights(a, lds, 0, WCONV_ALL, gw, NGW);
    float* ss = (float*)(ws + WS_SS);
    bf16_t* xb = (bf16_t*)(ws + WS_XB);
    for (int row0 = gw; row0 < MTOK; row0 += 4 * NGW) {
        f32x4 v[4][4];
#pragma unroll
        for (int r = 0; r < 4; ++r) { const int row = (row0 + r * NGW < MTOK) ? row0 + r * NGW : row0; const f32x4* xr = (const f32x4*)(a.in[0] + (size_t)row * 1024) + lane;
#pragma unroll
            for (int j = 0; j < 4; ++j) v[r][j] = __builtin_nontemporal_load(xr + 64 * j); }
#pragma unroll
        for (int r = 0; r < 4; ++r) { const int row = row0 + r * NGW; if (row < MTOK) { u32x2* o = (u32x2*)(xb + (size_t)row * 1024) + lane; float s = 0.f;
#pragma unroll
            for (int j = 0; j < 4; ++j) { const f32x4 x = v[r][j]; s += (x[0] * x[0] + x[1] * x[1]) + (x[2] * x[2] + x[3] * x[3]); u32x2 w; w.x = pk2(x[0], x[1]); w.y = pk2(x[2], x[3]); o[64 * j] = w; }
#pragma unroll
            for (int off = 1; off < 64; off <<= 1) s += __shfl_xor(s, off);
            if (lane == 0) ss[row] = s; } }
    }
    { f32x4* z = (f32x4*)(ss + MTOK); const int n4 = 6 * MTOK / 4; for (int i = blockIdx.x * 512 + tid; i < n4; i += gridDim.x * 512) z[i] = (f32x4){0.f, 0.f, 0.f, 0.f}; }
    { float* rope = (float*)(ws + WS_ROPE); const int* pos = (const int*)a.in[1];
      for (int i = blockIdx.x * 512 + tid; i < MTOK * 32; i += gridDim.x * 512) { const int tok = i >> 5, k = i & 31;
          const float inv = 1.0f / exp2f((float)k * 0.41524101186092029f);
          const float ang = (float)pos[tok] * inv;
          const double rr = (double)ang * 0.15915494309189535; const float fr_ = (float)(rr - rint(rr)) * 6.283185307179586f;
          rope[(size_t)tok * 64 + k] = cosf(fr_); rope[(size_t)tok * 64 + 32 + k] = sinf(fr_); } }
}

constexpr int HG_QI = 0, HG_KI = 17408, HG_QH = 34816, HG_KT = 52224, HG_IT = 70656, HG_PP = 89088, HG_ST = 98304, HG_REF = 133120, HG_TOT = 135680, HG_SS = 137728;
static_assert(HG_SS + 512 <= LDS_BYTES, "hgrn lds");
constexpr size_t HGS_QH = 0, HGS_KT = 16384, HGS_IT = 32768, HGS_PP = 49152, HGS_DEC = 57344, HGS_STRIDE = 57856;
static_assert(HGS_STRIDE * 2048 <= (size_t)MTOK * 1024 * 4, "hgrn scratch must fit in d_out");
constexpr size_t R1_SEG_OFF = (size_t)MTOK * 3072 * 2, R1_SEGD_OFF = R1_SEG_OFF + (size_t)256 * 65536;
constexpr int HL_QI = 0, HL_KI = 17408, HL_QH = 60928, HL_KT = 78336, HL_IT = 96768, HL_PP = 115200, HL_REF = 124416, HL_TOT = 126976;
static_assert(HL_TOT + 2048 <= LDS_BYTES - 16, "hgrn local lds");
__device__ __forceinline__ void hgrn_local_items(const Args& a, LAS unsigned char* lds, int item) {
    const int first = item * 8, stride = 1, last = first + 8;
    const int tid = threadIdx.x, wid = __builtin_amdgcn_readfirstlane(tid >> 6), lane = tid & 63, fr = lane & 15, g = lane >> 4;
    const int d = tid & 127, rg = tid >> 7;
    const bf16_t* P = (const bf16_t*)(a.ws + WS_R1);
    LAS float* REF = (LAS float*)(lds + HL_REF); LAS float* TOT = (LAS float*)(lds + HL_TOT);
    bf16_t rq[16], rf[16], ri[16];
    f32x4 S[8];
#pragma unroll
    for (int n = 0; n < 8; ++n) S[n] = (f32x4){0.f, 0.f, 0.f, 0.f};
    float dtot[4] = {1.f, 1.f, 1.f, 1.f};
    { const int bh = first >> 5, ch = first & 31; const bf16_t* pr = P + (size_t)((bh >> 2) * SEQ + ch * 64 + 16 * rg) * 3072 + (bh & 3) * 128 + d;
#pragma unroll
        for (int t = 0; t < 16; ++t) { rq[t] = pr[(size_t)t * 3072]; rf[t] = pr[(size_t)t * 3072 + 512]; ri[t] = pr[(size_t)t * 3072 + 1024]; } }
    const float lbv = sigmoidf_(a.in[9][((first >> 5) & 3) * 128 + d] - a.in[9][512 + ((first >> 5) & 3) * 128 + d]);
    for (int idx = first; idx < last; idx += stride) {
        const int bh = idx >> 5, h = bh & 3;
        unsigned char* scr = (unsigned char*)a.out + (size_t)idx * HGS_STRIDE;
        float qv[16], kv[16], bb[16];
        { float run = 0.f; unsigned iv[8];
#pragma unroll
          for (int t = 0; t < 16; ++t) { const float fp = bf2f(rf[t]); qv[t] = bf2f(rq[t]);
              const float f = lbv + (1.0f - lbv) * sigmoidf_(fp); run += __logf(f); bb[t] = run; kv[t] = 1.0f - f;
              const unsigned iraw = ri[t]; if (t & 1) iv[t >> 1] |= iraw << 16; else iv[t >> 1] = iraw; }
          TOT[rg * 128 + d] = run;
          *(LAS u32x4*)(lds + HL_IT + d * 144 + rg * 32) = (u32x4){iv[0], iv[1], iv[2], iv[3]};
          *(LAS u32x4*)(lds + HL_IT + d * 144 + rg * 32 + 16) = (u32x4){iv[4], iv[5], iv[6], iv[7]}; }
        if (idx + stride < last) { const int nx = idx + stride, nbh = nx >> 5, nch = nx & 31; const bf16_t* pr = P + (size_t)((nbh >> 2) * SEQ + nch * 64 + 16 * rg) * 3072 + (nbh & 3) * 128 + d;
#pragma unroll
            for (int t = 0; t < 16; ++t) { rq[t] = pr[(size_t)t * 3072]; rf[t] = pr[(size_t)t * 3072 + 512]; ri[t] = pr[(size_t)t * 3072 + 1024]; } }
        wg_barrier();
        { float off = 0.f;
#pragma unroll
          for (int r = 0; r < 3; ++r) { const float tv = TOT[r * 128 + d]; off += (r < rg) ? tv : 0.f; }
#pragma unroll
          for (int t = 0; t < 16; ++t) bb[t] += off;
          REF[rg * 128 + d] = bb[8]; if (rg == 3) REF[512 + d] = bb[15]; }
        wg_barrier();
        { const float blast = REF[512 + d]; const float e1 = __expf(bb[8]), ft = __expf(blast - bb[8]);
          float fI[4];
#pragma unroll
          for (int I = 0; I < 4; ++I) fI[I] = __expf(fminf(REF[I * 128 + d] - bb[8], 0.f));
          unsigned kp[8]; float kt0 = 0.f;
#pragma unroll
          for (int t = 0; t < 16; ++t) { const int row = 16 * rg + t; const float eo = __expf(bb[t] - bb[8]); const float qi = qv[t] * eo, ki = kv[t] * __builtin_amdgcn_rcpf(eo);
              *(LAS bf16_t*)(lds + HL_QI + row * 272 + d * 2) = f2bf(qi);
              *(LAS bf16_t*)(lds + HL_QH + row * 272 + d * 2) = f2bf(qi * e1);
#pragma unroll
              for (int I = 0; I < 4; ++I) if (I >= rg) *(LAS bf16_t*)(lds + HL_KI + (8 * I * (I + 1) + row) * 272 + d * 2) = f2bf(ki * fI[I]);
              const float ktv = ki * ft; if (t & 1) kp[t >> 1] = pk2(kt0, ktv); else kt0 = ktv; }
          *(LAS u32x4*)(lds + HL_KT + d * 144 + rg * 32) = (u32x4){kp[0], kp[1], kp[2], kp[3]};
          *(LAS u32x4*)(lds + HL_KT + d * 144 + rg * 32 + 16) = (u32x4){kp[4], kp[5], kp[6], kp[7]}; }
        wg_barrier();
#pragma unroll
        for (int kk = 0; kk < 2; ++kk) { const int tile = wid + 8 * kk, I = tile >> 2, J = tile & 3;
            if (J <= I) { f32x4 c = (f32x4){0.f, 0.f, 0.f, 0.f};
#pragma unroll
                for (int ks = 0; ks < 4; ++ks) c = mfma16(lds_frag(lds, HL_QI + (16 * I + fr) * 272 + ks * 64 + g * 16), lds_frag(lds, HL_KI + (8 * I * (I + 1) + 16 * J + fr) * 272 + ks * 64 + g * 16), c);
#pragma unroll
                for (int j = 0; j < 4; ++j) { float v = c[j]; if (J == I && fr > 4 * g + j) v = 0.f; *(LAS bf16_t*)(lds + HL_PP + (16 * I + 4 * g + j) * 144 + (16 * J + fr) * 2) = f2bf(v); }
            } else {
#pragma unroll
                for (int j = 0; j < 4; ++j) *(LAS bf16_t*)(lds + HL_PP + (16 * I + 4 * g + j) * 144 + (16 * J + fr) * 2) = (bf16_t)0;
            } }
        wg_barrier();
        { float dec[4];
#pragma unroll
          for (int j = 0; j < 4; ++j) { dec[j] = __expf(REF[512 + 16 * wid + 4 * g + j]); dtot[j] *= dec[j]; }
#pragma unroll
          for (int n = 0; n < 8; ++n)
#pragma unroll
              for (int j = 0; j < 4; ++j) S[n][j] *= dec[j];
#pragma unroll
          for (int ks = 0; ks < 2; ++ks) { const bf16x8 av = lds_frag(lds, HL_KT + (16 * wid + fr) * 144 + ks * 64 + g * 16);
#pragma unroll
              for (int n = 0; n < 8; ++n) S[n] = mfma16(av, lds_frag(lds, HL_IT + (16 * n + fr) * 144 + ks * 64 + g * 16), S[n]); } }
#pragma unroll
        for (int k = 0; k < 2; ++k) { const int e = tid + 512 * k;
            *(u32x4*)(scr + HGS_QH + (size_t)e * 16) = *(const LAS u32x4*)(lds + HL_QH + (e >> 4) * 272 + (e & 15) * 16);
            *(u32x4*)(scr + HGS_KT + (size_t)e * 16) = *(const LAS u32x4*)(lds + HL_KT + (e >> 3) * 144 + (e & 7) * 16);
            *(u32x4*)(scr + HGS_IT + (size_t)e * 16) = *(const LAS u32x4*)(lds + HL_IT + (e >> 3) * 144 + (e & 7) * 16); }
        *(u32x4*)(scr + HGS_PP + (size_t)tid * 16) = *(const LAS u32x4*)(lds + HL_PP + (tid >> 3) * 144 + (tid & 7) * 16);
        if (tid < 128) ((float*)(scr + HGS_DEC))[tid] = __expf(REF[512 + tid]);
        wg_barrier();
    }
    { f32x4* so = (f32x4*)(a.ws + WS_R1 + R1_SEG_OFF + (size_t)item * 65536) + (size_t)wid * 512 + lane;
#pragma unroll
      for (int n = 0; n < 8; ++n) so[n * 64] = S[n];
      if (fr == 0) *(f32x4*)((float*)(a.ws + WS_R1 + R1_SEGD_OFF) + (size_t)item * 128 + 16 * wid + 4 * g) = (f32x4){dtot[0], dtot[1], dtot[2], dtot[3]}; }
}
constexpr size_t R1_SEG = (size_t)MTOK * 3072 * 2;
constexpr size_t R1_SEGD = R1_SEG + (size_t)256 * 65536;
static_assert(R1_SEGD + 256 * 512 <= R1_BYTES, "segment scratch");
__device__ __forceinline__ void hgrn_seg_state(const Args& a, LAS unsigned char* lds, int item) {
    const int tid = threadIdx.x, wid = __builtin_amdgcn_readfirstlane(tid >> 6), lane = tid & 63, fr = lane & 15, g = lane >> 4;
    const int bh = item >> 2, seg = item & 3;
    const unsigned char* scr0 = (const unsigned char*)a.out + ((size_t)bh * 32 + seg * 8) * HGS_STRIDE;
    LAS float* DEC = (LAS float*)(lds + HG_REF);
    f32x4 S[8];
#pragma unroll
    for (int n = 0; n < 8; ++n) S[n] = (f32x4){0.f, 0.f, 0.f, 0.f};
    float dtot[4] = {1.f, 1.f, 1.f, 1.f};
    u32x4 rk[2], ri[2]; float rd = 0.f;
#pragma unroll
    for (int k = 0; k < 2; ++k) { const unsigned e = tid + 512 * k; rk[k] = *(const u32x4*)(scr0 + HGS_KT + e * 16); ri[k] = *(const u32x4*)(scr0 + HGS_IT + e * 16); }
    if (tid < 128) rd = ((const float*)(scr0 + HGS_DEC))[tid];
    for (int c = 0; c < 8; ++c) {
#pragma unroll
        for (int k = 0; k < 2; ++k) { const int e = tid + 512 * k;
            *(LAS u32x4*)(lds + HG_KT + (e >> 3) * 144 + (e & 7) * 16) = rk[k];
            *(LAS u32x4*)(lds + HG_IT + (e >> 3) * 144 + (e & 7) * 16) = ri[k]; }
        if (tid < 128) DEC[tid] = rd;
        wg_barrier();
        if (c + 1 < 8) { const unsigned char* sc = scr0 + (size_t)(c + 1) * HGS_STRIDE;
#pragma unroll
            for (int k = 0; k < 2; ++k) { const unsigned e = tid + 512 * k; rk[k] = *(const u32x4*)(sc + HGS_KT + e * 16); ri[k] = *(const u32x4*)(sc + HGS_IT + e * 16); }
            if (tid < 128) rd = ((const float*)(sc + HGS_DEC))[tid]; }
        float dec[4];
#pragma unroll
        for (int j = 0; j < 4; ++j) { dec[j] = DEC[16 * wid + 4 * g + j]; dtot[j] *= dec[j]; }
#pragma unroll
        for (int n = 0; n < 8; ++n)
#pragma unroll
            for (int j = 0; j < 4; ++j) S[n][j] *= dec[j];
#pragma unroll
        for (int ks = 0; ks < 2; ++ks) { const bf16x8 av = lds_frag(lds, HG_KT + (16 * wid + fr) * 144 + ks * 64 + g * 16);
#pragma unroll
            for (int n = 0; n < 8; ++n) S[n] = mfma16(av, lds_frag(lds, HG_IT + (16 * n + fr) * 144 + ks * 64 + g * 16), S[n]); }
        wg_barrier();
    }
    f32x4* so = (f32x4*)(a.ws + WS_R1 + R1_SEG + (size_t)item * 65536) + (size_t)wid * 512 + lane;
#pragma unroll
    for (int n = 0; n < 8; ++n) so[n * 64] = S[n];
    if (fr == 0) *(f32x4*)((float*)(a.ws + WS_R1 + R1_SEGD) + (size_t)item * 128 + 16 * wid + 4 * g) = (f32x4){dtot[0], dtot[1], dtot[2], dtot[3]};
}
__device__ __forceinline__ void hgrn_seq_item(const Args& a, LAS unsigned char* lds, int item) {
    const int tid = threadIdx.x, wid = __builtin_amdgcn_readfirstlane(tid >> 6), lane = tid & 63, fr = lane & 15, g = lane >> 4;
    const int bh = item >> 2, seg = item & 3, ch_lo = seg * 8, ch_hi = ch_lo + 8;
    const int b = bh >> 2, h = bh & 3;
    const bf16_t* P = (const bf16_t*)(a.ws + WS_R1);
    bf16_t* cat = (bf16_t*)(a.ws + WS_CAT);
    const unsigned char* scr0 = (const unsigned char*)a.out + ((size_t)bh * 32 + ch_lo) * HGS_STRIDE;
    LAS float* DEC = (LAS float*)(lds + HG_REF); LAS float* SSQ = (LAS float*)(lds + HG_SS);
    f32x4 S[8];
#pragma unroll
    for (int n = 0; n < 8; ++n) S[n] = (f32x4){0.f, 0.f, 0.f, 0.f};
    for (int sp = 0; sp < seg; ++sp) {
        const f32x4* si = (const f32x4*)(a.ws + WS_R1 + R1_SEG + (size_t)(bh * 4 + sp) * 65536) + (size_t)wid * 512 + lane;
        const f32x4 dd = *(const f32x4*)((const float*)(a.ws + WS_R1 + R1_SEGD) + (size_t)(bh * 4 + sp) * 128 + 16 * wid + 4 * g);
#pragma unroll
        for (int n = 0; n < 8; ++n) S[n] = S[n] * dd + si[n * 64];
    }
#pragma unroll
    for (int n = 0; n < 8; ++n) { u32x2 w; w.x = pk2(S[n][0], S[n][1]); w.y = pk2(S[n][2], S[n][3]); *(LAS u32x2*)(lds + HG_ST + (16 * n + fr) * 272 + (16 * wid + 4 * g) * 2) = w; }
    const int tt_o = wid >> 1, dvh = wid & 1;
    float gn[4];
#pragma unroll
    for (int n = 0; n < 4; ++n) gn[n] = a.in[10][h * 128 + dvh * 64 + 16 * n + fr];
    u32x4 rq[2], rk[2], ri[2], rp; float rd = 0.f;
#pragma unroll
    for (int k = 0; k < 2; ++k) { const unsigned e = tid + 512 * k; rq[k] = *(const u32x4*)(scr0 + HGS_QH + e * 16); rk[k] = *(const u32x4*)(scr0 + HGS_KT + e * 16); ri[k] = *(const u32x4*)(scr0 + HGS_IT + e * 16); }
    rp = *(const u32x4*)(scr0 + HGS_PP + (unsigned)tid * 16); if (tid < 128) rd = ((const float*)(scr0 + HGS_DEC))[tid];
    f32x4 O[4];
#pragma unroll
    for (int n = 0; n < 4; ++n) O[n] = (f32x4){0.f, 0.f, 0.f, 0.f};
    bf16_t gq[4][4];
#pragma unroll
    for (int j = 0; j < 4; ++j)
#pragma unroll
        for (int n = 0; n < 4; ++n) gq[j][n] = 0;
    for (int ch = ch_lo; ch <= ch_hi; ++ch) {
        if (ch > ch_lo) {
            const int tok0 = b * SEQ + (ch - 1) * 64;
#pragma unroll
            for (int n = 0; n < 8; ++n) { u32x2 w; w.x = pk2(S[n][0], S[n][1]); w.y = pk2(S[n][2], S[n][3]); *(LAS u32x2*)(lds + HG_ST + (16 * n + fr) * 272 + (16 * wid + 4 * g) * 2) = w; }
#pragma unroll
            for (int j = 0; j < 4; ++j) { const int t = 16 * tt_o + 4 * g + j; const float rstd = rsqrtf((SSQ[t] + SSQ[64 + t]) * (1.0f / 128.0f) + EPS);
                const size_t tok = (size_t)(tok0 + t);
#pragma unroll
                for (int n = 0; n < 4; ++n) { const int dv = dvh * 64 + 16 * n + fr; const float gval = bf2f(gq[j][n]);
                    cat[tok * 1024 + h * 128 + dv] = f2bf(O[n][j] * rstd * gn[n] * siluf_(gval)); } }
        }
        if (ch == ch_hi) break;
#pragma unroll
        for (int k = 0; k < 2; ++k) { const int e = tid + 512 * k;
            *(LAS u32x4*)(lds + HG_QH + (e >> 4) * 272 + (e & 15) * 16) = rq[k];
            *(LAS u32x4*)(lds + HG_KT + (e >> 3) * 144 + (e & 7) * 16) = rk[k];
            *(LAS u32x4*)(lds + HG_IT + (e >> 3) * 144 + (e & 7) * 16) = ri[k]; }
        *(LAS u32x4*)(lds + HG_PP + (tid >> 3) * 144 + (tid & 7) * 16) = rp;
        if (tid < 128) DEC[tid] = rd;
        wg_barrier();
        if (ch + 1 < ch_hi) { const unsigned char* sc = scr0 + (size_t)(ch + 1 - ch_lo) * HGS_STRIDE;
#pragma unroll
            for (int k = 0; k < 2; ++k) { const unsigned e = tid + 512 * k; rq[k] = *(const u32x4*)(sc + HGS_QH + e * 16); rk[k] = *(const u32x4*)(sc + HGS_KT + e * 16); ri[k] = *(const u32x4*)(sc + HGS_IT + e * 16); }
            rp = *(const u32x4*)(sc + HGS_PP + (unsigned)tid * 16); if (tid < 128) rd = ((const float*)(sc + HGS_DEC))[tid]; }
        { const bf16_t* gp = P + (size_t)(b * SEQ + ch * 64 + 16 * tt_o + 4 * g) * 3072 + 1536 + h * 128 + dvh * 64 + fr;
#pragma unroll
          for (int j = 0; j < 4; ++j)
#pragma unroll
              for (int n = 0; n < 4; ++n) gq[j][n] = gp[(size_t)j * 3072 + 16 * n]; }
#pragma unroll
        for (int n = 0; n < 4; ++n) O[n] = (f32x4){0.f, 0.f, 0.f, 0.f};
#pragma unroll
        for (int ks = 0; ks < 4; ++ks) { const bf16x8 av = lds_frag(lds, HG_QH + (16 * tt_o + fr) * 272 + ks * 64 + g * 16);
#pragma unroll
            for (int n = 0; n < 4; ++n) O[n] = mfma16(av, lds_frag(lds, HG_ST + (dvh * 64 + 16 * n + fr) * 272 + ks * 64 + g * 16), O[n]); }
        for (int ks = 0; ks <= (tt_o >> 1); ++ks) { const bf16x8 av = lds_frag(lds, HG_PP + (16 * tt_o + fr) * 144 + ks * 64 + g * 16);
#pragma unroll
            for (int n = 0; n < 4; ++n) O[n] = mfma16(av, lds_frag(lds, HG_IT + (dvh * 64 + 16 * n + fr) * 144 + ks * 64 + g * 16), O[n]); }
#pragma unroll
        for (int j = 0; j < 4; ++j) { float s = O[0][j] * O[0][j] + O[1][j] * O[1][j] + O[2][j] * O[2][j] + O[3][j] * O[3][j];
            s += __shfl_xor(s, 1); s += __shfl_xor(s, 2); s += __shfl_xor(s, 4); s += __shfl_xor(s, 8);
            if (fr == 0) SSQ[dvh * 64 + 16 * tt_o + 4 * g + j] = s; }
        { float dec[4];
#pragma unroll
          for (int j = 0; j < 4; ++j) dec[j] = DEC[16 * wid + 4 * g + j];
#pragma unroll
          for (int n = 0; n < 8; ++n)
#pragma unroll
              for (int j = 0; j < 4; ++j) S[n][j] *= dec[j];
#pragma unroll
          for (int ks = 0; ks < 2; ++ks) { const bf16x8 av = lds_frag(lds, HG_KT + (16 * wid + fr) * 144 + ks * 64 + g * 16);
#pragma unroll
              for (int n = 0; n < 8; ++n) S[n] = mfma16(av, lds_frag(lds, HG_IT + (16 * n + fr) * 144 + ks * 64 + g * 16), S[n]); } }
        wg_barrier();
    }
    wg_barrier();
}

constexpr int SG_W = 0, SG_V = 34816;
typedef short v4i16_t __attribute__((ext_vector_type(4)));
__device__ __forceinline__ void sgu_items(const Args& a, LAS unsigned char* lds, int first, int stride) {
    const int tid = threadIdx.x, wid = __builtin_amdgcn_readfirstlane(tid >> 6), lane = tid & 63, fr = lane & 15, g = lane >> 4;
    const int gi = first & 3;
    const bf16_t* P = (const bf16_t*)(a.ws + WS_R1);
    bf16_t* cat = (bf16_t*)(a.ws + WS_CAT);
    { const float* W = a.in[13] + (size_t)gi * 16384;
#pragma unroll
      for (int k = 0; k < 4; ++k) { const int e = tid + 512 * k, t = e >> 4, s0 = (e & 15) * 8; const f32x4 w0 = *(const f32x4*)(W + t * 128 + s0), w1 = *(const f32x4*)(W + t * 128 + s0 + 4);
          float v[8] = {w0[0], w0[1], w0[2], w0[3], w1[0], w1[1], w1[2], w1[3]};
#pragma unroll
          for (int j = 0; j < 8; ++j) if (s0 + j > t) v[j] = 0.f;
          *(LAS u32x4*)(lds + SG_W + t * 272 + s0 * 2) = (u32x4){pk2(v[0], v[1]), pk2(v[2], v[3]), pk2(v[4], v[5]), pk2(v[6], v[7])}; } }
    const int cg = tid & 15, srow = tid >> 4;
    float lgv[8], lbv[8];
#pragma unroll
    for (int j = 0; j < 8; ++j) { lgv[j] = a.in[11][gi * 128 + 8 * cg + j]; lbv[j] = a.in[12][gi * 128 + 8 * cg + j]; }
    const int q = fr >> 2, pp = fr & 3;
    const float bs = a.in[14][gi * 128 + 16 * wid + fr];
    u32x4 rv[4];
    if (first < 1024) {
#pragma unroll
        for (int k = 0; k < 4; ++k) rv[k] = *(const u32x4*)(P + (size_t)((first >> 2) * 128 + srow + 32 * k) * 3072 + 2560 + gi * 128 + 8 * cg); }
    for (int it = first; it < 1024; it += stride) {
        const int tok0 = (it >> 2) * 128;
#pragma unroll
        for (int k = 0; k < 4; ++k) { float x[8] = {bflo(rv[k].x), bfhi(rv[k].x), bflo(rv[k].y), bfhi(rv[k].y), bflo(rv[k].z), bfhi(rv[k].z), bflo(rv[k].w), bfhi(rv[k].w)};
            float s1 = 0.f, s2 = 0.f;
#pragma unroll
            for (int j = 0; j < 8; ++j) { s1 += x[j]; s2 += x[j] * x[j]; }
#pragma unroll
            for (int off = 1; off < 16; off <<= 1) { s1 += __shfl_xor(s1, off); s2 += __shfl_xor(s2, off); }
            const float mean = s1 * (1.0f / 128.0f), rstd = rsqrtf(fmaxf(s2 * (1.0f / 128.0f) - mean * mean, 0.f) + EPS);
#pragma unroll
            for (int j = 0; j < 8; ++j) x[j] = (x[j] - mean) * rstd * lgv[j] + lbv[j];
            *(LAS u32x4*)(lds + SG_V + (srow + 32 * k) * 272 + cg * 16) = (u32x4){pk2(x[0], x[1]), pk2(x[2], x[3]), pk2(x[4], x[5]), pk2(x[6], x[7])}; }
        wg_barrier();
        if (it + stride < 1024) {
#pragma unroll
            for (int k = 0; k < 4; ++k) rv[k] = *(const u32x4*)(P + (size_t)(((it + stride) >> 2) * 128 + srow + 32 * k) * 3072 + 2560 + gi * 128 + 8 * cg); }
        u32x2 uu[8];
        { const bf16_t* up = P + (size_t)(tok0 + 16 * wid + fr) * 3072 + 2048 + gi * 128 + 4 * g;
#pragma unroll
          for (int m = 0; m < 8; ++m) uu[m] = *(const u32x2*)(up + 16 * m); }
        f32x4 Z[8];
#pragma unroll
        for (int m = 0; m < 8; ++m) Z[m] = (f32x4){0.f, 0.f, 0.f, 0.f};
        for (int ks = 0; ks <= (wid >> 1); ++ks) { const bf16x8 bw = lds_frag(lds, SG_W + (16 * wid + fr) * 272 + ks * 64 + g * 16);
#pragma unroll
            for (int m = 0; m < 8; ++m) { LAS unsigned char* ap = lds + SG_V + (32 * ks + 8 * g + q) * 272 + (16 * m + 4 * pp) * 2;
                const v4i16_t a0 = __builtin_amdgcn_ds_read_tr16_b64_v4i16((LAS v4i16_t*)ap), a1 = __builtin_amdgcn_ds_read_tr16_b64_v4i16((LAS v4i16_t*)(ap + 4 * 272));
                const bf16x8 av = (bf16x8){a0[0], a0[1], a0[2], a0[3], a1[0], a1[1], a1[2], a1[3]};
                Z[m] = mfma16(av, bw, Z[m]); } }
        { const int t = 16 * wid + fr; const size_t tok = (size_t)(tok0 + t);
          bf16_t* op = cat + tok * 1024 + 512 + gi * 128 + 4 * g;
#pragma unroll
          for (int m = 0; m < 8; ++m) { u32x2 w; w.x = pk2(bflo(uu[m].x) * (Z[m][0] + bs), bfhi(uu[m].x) * (Z[m][1] + bs)); w.y = pk2(bflo(uu[m].y) * (Z[m][2] + bs), bfhi(uu[m].y) * (Z[m][3] + bs)); *(u32x2*)(op + 16 * m) = w; } }
        wg_barrier();
    }
}

__device__ __forceinline__ void conv_items(const Args& a, LAS unsigned char* lds) {
    const int tid = threadIdx.x, wid = tid >> 6, lane = tid & 63, c = tid;
    const bf16_t* H = (const bf16_t*)(a.ws + WS_R1 + R1_HGLU);
    bf16_t* cat = (bf16_t*)(a.ws + WS_CAT);
    LAS float* YS = (LAS float*)lds; LAS float* ST2 = (LAS float*)(lds + 32768);
    float w[31];
#pragma unroll
    for (int j = 0; j < 31; ++j) w[j] = a.in[17][j * 512 + c];
    const float cb = a.in[18][c], lg = a.in[19][c], lb = a.in[20][c];
    bf16_t xr[46];
    if ((int)blockIdx.x < MTOK / 16) { const int tok0 = blockIdx.x * 16, t0 = tok0 & 2047;
#pragma unroll
        for (int i = 0; i < 46; ++i) { const int t = t0 - 30 + i; xr[i] = H[(size_t)(tok0 + (t >= 0 ? i - 30 : 0)) * 512 + c]; } }
    for (int item = blockIdx.x; item < MTOK / 16; item += gridDim.x) {
        const int tok0 = item * 16, t0 = tok0 & 2047;
        float x[46];
#pragma unroll
        for (int i = 0; i < 46; ++i) { const int t = t0 - 30 + i; x[i] = (t >= 0) ? bf2f(xr[i]) : 0.f; }
        if (item + (int)gridDim.x < MTOK / 16) { const int ntok0 = (item + gridDim.x) * 16, nt0 = ntok0 & 2047;
#pragma unroll
            for (int i = 0; i < 46; ++i) { const int t = nt0 - 30 + i; xr[i] = H[(size_t)(ntok0 + (t >= 0 ? i - 30 : 0)) * 512 + c]; } }
        float y[16];
#pragma unroll
        for (int o = 0; o < 16; ++o) { float s = cb;
#pragma unroll
            for (int j = 0; j < 31; ++j) s += w[j] * x[o + j];
            y[o] = s; YS[o * 512 + c] = s; }
        wg_barrier();
#pragma unroll
        for (int k = 0; k < 2; ++k) { const int o = 2 * wid + k; float v[8]; float sm = 0.f;
#pragma unroll
            for (int i = 0; i < 8; ++i) { v[i] = YS[o * 512 + lane + 64 * i]; sm += v[i]; }
#pragma unroll
            for (int off = 1; off < 64; off <<= 1) sm += __shfl_xor(sm, off);
            const float mean = sm * (1.0f / 512.0f); float q = 0.f;
#pragma unroll
            for (int i = 0; i < 8; ++i) q += (v[i] - mean) * (v[i] - mean);
#pragma unroll
            for (int off = 1; off < 64; off <<= 1) q += __shfl_xor(q, off);
            if (lane == 0) { ST2[2 * o] = mean; ST2[2 * o + 1] = rsqrtf(q * (1.0f / 512.0f) + EPS); } }
        wg_barrier();
#pragma unroll
        for (int o = 0; o < 16; ++o) { const float v = (y[o] - ST2[2 * o]) * ST2[2 * o + 1] * lg + lb; cat[(size_t)(tok0 + o) * 1024 + c] = f2bf(siluf_(v)); }
        wg_barrier();
    }
}
__device__ __forceinline__ void krope_items(const Args& a) {
    const bf16_t* pq = (const bf16_t*)(a.ws + WS_R1 + R1_PQKV); bf16_t* Kb = (bf16_t*)(a.ws + WS_R1 + R1_KB); const float* rope = (const float*)(a.ws + WS_ROPE);
    for (int i = blockIdx.x * 512 + threadIdx.x; i < MTOK * 4; i += gridDim.x * 512) { const int tok = i >> 2, k8 = (i & 3) * 8;
        const u32x4 r1 = *(const u32x4*)(pq + (size_t)tok * 768 + 640 + k8), r2 = *(const u32x4*)(pq + (size_t)tok * 768 + 672 + k8);
        const float* rp = rope + (size_t)tok * 64 + k8; const f32x4 c0 = *(const f32x4*)rp, c1 = *(const f32x4*)(rp + 4), s0 = *(const f32x4*)(rp + 32), s1 = *(const f32x4*)(rp + 36);
        const float x1[8] = {bflo(r1.x), bfhi(r1.x), bflo(r1.y), bfhi(r1.y), bflo(r1.z), bfhi(r1.z), bflo(r1.w), bfhi(r1.w)}, x2[8] = {bflo(r2.x), bfhi(r2.x), bflo(r2.y), bfhi(r2.y), bflo(r2.z), bfhi(r2.z), bflo(r2.w), bfhi(r2.w)};
        const float cs[8] = {c0[0], c0[1], c0[2], c0[3], c1[0], c1[1], c1[2], c1[3]}, sn[8] = {s0[0], s0[1], s0[2], s0[3], s1[0], s1[1], s1[2], s1[3]};
        float o1[8], o2[8];
#pragma unroll
        for (int j = 0; j < 8; ++j) { o1[j] = x1[j] * cs[j] - x2[j] * sn[j]; o2[j] = x1[j] * sn[j] + x2[j] * cs[j]; }
        const u32x4 w1 = (u32x4){pk2(o1[0], o1[1]), pk2(o1[2], o1[3]), pk2(o1[4], o1[5]), pk2(o1[6], o1[7])}, w2 = (u32x4){pk2(o2[0], o2[1]), pk2(o2[2], o2[3]), pk2(o2[4], o2[5]), pk2(o2[6], o2[7])};
        const int b = tok >> 11, t = tok & 2047;
#pragma unroll
        for (int h = 0; h < 4; ++h) { bf16_t* kr = Kb + ((size_t)(b * 4 + h) * 2048 + t) * 192 + 128 + k8; *(u32x4*)kr = w1; *(u32x4*)(kr + 32) = w2; } }
}

constexpr int AT_K = 0, AT_V = 67584, AT_KB = 33792, AT_VB = 18432;
__device__ __forceinline__ void attn_items(const Args& a, LAS unsigned char* lds) {
    const int tid = threadIdx.x, wid = __builtin_amdgcn_readfirstlane(tid >> 6), lane = tid & 63, fr = lane & 15, g = lane >> 4;
    const bf16_t* Q = (const bf16_t*)(a.ws + WS_R1 + R1_Q); const bf16_t* Kb = (const bf16_t*)(a.ws + WS_R1 + R1_KB); const bf16_t* Vt = (const bf16_t*)(a.ws + WS_R1 + R1_VT);
    const float* rope = (const float*)(a.ws + WS_ROPE); bf16_t* cat = (bf16_t*)(a.ws + WS_CAT);
    for (int item0 = blockIdx.x; item0 < 256; item0 += gridDim.x) {
        const int item = (gridDim.x == 256) ? ((item0 & 7) * 32 + (item0 >> 3)) : item0;
        const int bh = item >> 2, p = item & 3, b = bh >> 2, h = bh & 3;
        const unsigned char* kbase = (const unsigned char*)(Kb + (size_t)bh * 2048 * 192);
        const unsigned char* vbase = (const unsigned char*)(Vt + (size_t)bh * 2048 * 128);
        for (int half = 0; half < 2; ++half) {
            const int qb = half ? 7 - p : p;
            const int q0 = qb * 256 + wid * 32;
            u32x4 kreg[3], vreg[2];
#pragma unroll
            for (int k = 0; k < 3; ++k) kreg[k] = *(const u32x4*)(kbase + (unsigned)(tid * 16 + 8192 * k));
#pragma unroll
            for (int k = 0; k < 2; ++k) { const int e = tid + 512 * k; vreg[k] = *(const u32x4*)(vbase + (unsigned)(e * 16)); }
            bf16x8 qf[2][6];
#pragma unroll
            for (int qt = 0; qt < 2; ++qt) { const size_t tok = (size_t)b * SEQ + q0 + 16 * qt + fr; const bf16_t* qr = Q + tok * 768 + h * 192 + 8 * g;
#pragma unroll
                for (int ks = 0; ks < 6; ++ks) qf[qt][ks] = *(const bf16x8*)(qr + 32 * ks);
                const float* rp = rope + tok * 64 + 8 * g; const f32x4 c0 = *(const f32x4*)rp, c1 = *(const f32x4*)(rp + 4), s0 = *(const f32x4*)(rp + 32), s1 = *(const f32x4*)(rp + 36);
                const float cs[8] = {c0[0], c0[1], c0[2], c0[3], c1[0], c1[1], c1[2], c1[3]}, sn[8] = {s0[0], s0[1], s0[2], s0[3], s1[0], s1[1], s1[2], s1[3]};
                bf16x8 r1, r2;
#pragma unroll
                for (int j = 0; j < 8; ++j) { const float x1 = bf2f((bf16_t)qf[qt][4][j]), x2 = bf2f((bf16_t)qf[qt][5][j]);
                    r1[j] = (short)f2bf(x1 * cs[j] - x2 * sn[j]); r2[j] = (short)f2bf(x1 * sn[j] + x2 * cs[j]); }
                qf[qt][4] = r1; qf[qt][5] = r2; }
            f32x4 O[8][2];
#pragma unroll
            for (int mt = 0; mt < 8; ++mt) { O[mt][0] = (f32x4){0.f, 0.f, 0.f, 0.f}; O[mt][1] = (f32x4){0.f, 0.f, 0.f, 0.f}; }
            float mrow[2] = {-1e30f, -1e30f}, lrow[2] = {0.f, 0.f};
            const int ntile = qb * 4 + 4;
#pragma unroll
            for (int k = 0; k < 3; ++k) { const int e = tid + 512 * k; const int r_ = e / 24, c_ = e % 24; *(LAS u32x4*)(lds + AT_K + r_ * 528 + ((c_ ^ (((r_ + 4) >> 3) & 1)) * 16)) = kreg[k]; }
#pragma unroll
            for (int k = 0; k < 2; ++k) { const int e = tid + 512 * k; *(LAS u32x4*)(lds + AT_V + (e >> 4) * 288 + (e & 15) * 16) = vreg[k]; }
            wg_barrier();
            for (int kt = 0; kt < ntile; ++kt) {
                const int buf = kt & 1; const bool more = kt + 1 < ntile;
                LAS unsigned char* ks_ = lds + AT_K + buf * AT_KB; LAS unsigned char* vs_ = lds + AT_V + buf * AT_VB; const int gx = (g ^ (((fr + 4) >> 3) & 1)) * 16;
                if (more) {
#pragma unroll
                    for (int k = 0; k < 3; ++k) kreg[k] = *(const u32x4*)(kbase + (size_t)(kt + 1) * 24576 + (unsigned)(tid * 16 + 8192 * k));
#pragma unroll
                    for (int k = 0; k < 2; ++k) { const int e = tid + 512 * k; vreg[k] = *(const u32x4*)(vbase + (size_t)(kt + 1) * 16384 + (unsigned)(e * 16)); }
                }
#pragma unroll
                for (int u = 0; u < 2; ++u) {
                    if (kt * 64 + 32 * u <= q0) {
                        f32x4 st[2][2];
#pragma unroll
                        for (int kk = 0; kk < 2; ++kk) { st[kk][0] = (f32x4){0.f, 0.f, 0.f, 0.f}; st[kk][1] = (f32x4){0.f, 0.f, 0.f, 0.f};
#pragma unroll
                            for (int ks = 0; ks < 6; ++ks) { const bf16x8 kf = lds_frag(ks_, (16 * (2 * u + kk) + fr) * 528 + ks * 64 + gx);
                                st[kk][0] = mfma16(kf, qf[0][ks], st[kk][0]); st[kk][1] = mfma16(kf, qf[1][ks], st[kk][1]); } }
                        if (kt * 64 + 32 * u == q0) {
#pragma unroll
                            for (int kk = 0; kk < 2; ++kk)
#pragma unroll
                                for (int qt = 0; qt < 2; ++qt)
#pragma unroll
                                    for (int j = 0; j < 4; ++j) if (16 * kk + 4 * g + j > 16 * qt + fr) st[kk][qt][j] = -INFINITY;
                        }
                        bf16x8 pb[2];
#pragma unroll
                        for (int qt = 0; qt < 2; ++qt) { float mx = -INFINITY;
#pragma unroll
                            for (int kk = 0; kk < 2; ++kk)
#pragma unroll
                                for (int j = 0; j < 4; ++j) mx = fmaxf(mx, st[kk][qt][j]);
                            mx = xor16_max(mx); mx = xor32_max(mx);
                            const bool need = mx > mrow[qt] + 8.0f;
                            if (__builtin_amdgcn_ballot_w64(need) != 0ull) { const float mnew = need ? mx : mrow[qt], alpha = __builtin_amdgcn_exp2f(mrow[qt] - mnew); mrow[qt] = mnew; lrow[qt] *= alpha;
#pragma unroll
                                for (int mt = 0; mt < 8; ++mt) O[mt][qt] *= alpha; }
                            const float mref = mrow[qt]; float ls = 0.f;
#pragma unroll
                            for (int kk = 0; kk < 2; ++kk)
#pragma unroll
                                for (int j = 0; j < 4; ++j) { const float pv = __builtin_amdgcn_exp2f(st[kk][qt][j] - mref); st[kk][qt][j] = pv; ls += pv; }
                            lrow[qt] += ls;
                            pb[qt] = __builtin_bit_cast(bf16x8, (u32x4){pk2(st[0][qt][0], st[0][qt][1]), pk2(st[0][qt][2], st[0][qt][3]), pk2(st[1][qt][0], st[1][qt][1]), pk2(st[1][qt][2], st[1][qt][3])}); }
#pragma unroll
                        for (int mt = 0; mt < 8; ++mt) { LAS unsigned char* vp_ = vs_ + (32 * u + 4 * g + (fr >> 2)) * 288 + (16 * mt + 4 * (fr & 3)) * 2;
                            const v4i16_t a0 = __builtin_amdgcn_ds_read_tr16_b64_v4i16((LAS v4i16_t*)vp_), a1 = __builtin_amdgcn_ds_read_tr16_b64_v4i16((LAS v4i16_t*)(vp_ + 16 * 288));
                            const bf16x8 vf = (bf16x8){a0[0], a0[1], a0[2], a0[3], a1[0], a1[1], a1[2], a1[3]};
                            O[mt][0] = mfma16(vf, pb[0], O[mt][0]); O[mt][1] = mfma16(vf, pb[1], O[mt][1]); }
                    }
                    if (more) {
                        if (u == 0) {
#pragma unroll
                            for (int k = 0; k < 3; ++k) { const int e = tid + 512 * k; const int r_ = e / 24, c_ = e % 24; *(LAS u32x4*)(lds + AT_K + (buf ^ 1) * AT_KB + r_ * 528 + ((c_ ^ (((r_ + 4) >> 3) & 1)) * 16)) = kreg[k]; }
                        } else {
#pragma unroll
                            for (int k = 0; k < 2; ++k) { const int e = tid + 512 * k; *(LAS u32x4*)(lds + AT_V + (buf ^ 1) * AT_VB + (e >> 4) * 288 + (e & 15) * 16) = vreg[k]; }
                        }
                    }
                }
                wg_barrier();
            }
#pragma unroll
            for (int qt = 0; qt < 2; ++qt) { float l = lrow[qt]; l += __shfl_xor(l, 16); l += __shfl_xor(l, 32); const float inv = 1.0f / l;
                bf16_t* orow = cat + ((size_t)b * SEQ + q0 + 16 * qt + fr) * 1024 + 512 + h * 128 + 4 * g;
#pragma unroll
                for (int mt = 0; mt < 8; ++mt) { u32x2 w; w.x = pk2(O[mt][qt][0] * inv, O[mt][qt][1] * inv); w.y = pk2(O[mt][qt][2] * inv, O[mt][qt][3] * inv); *(u32x2*)(orow + 16 * mt) = w; } }
        }
    }
}

__device__ __forceinline__ void final_norm(const Args& a) {
    const float* ss4 = (const float*)(a.ws + WS_SS) + 4 * MTOK; const bf16_t* xb = (const bf16_t*)(a.ws + WS_XB);
    const int stride = gridDim.x * 512;
    for (int i0 = blockIdx.x * 512 + threadIdx.x; i0 < MTOK * 128; i0 += 4 * stride) {
        u32x4 r[4]; float sq[4];
#pragma unroll
        for (int k = 0; k < 4; ++k) { const int i = (i0 + k * stride < MTOK * 128) ? i0 + k * stride : i0; r[k] = *(const u32x4*)(xb + (size_t)(i >> 7) * 1024 + (i & 127) * 8); sq[k] = ss4[i >> 7]; }
#pragma unroll
        for (int k = 0; k < 4; ++k) { const int i = i0 + k * stride; if (i < MTOK * 128) { const int row = i >> 7, c8 = (i & 127) * 8;
            const float rstd = rsqrtf(sq[k] * (1.0f / 1024.0f) + EPS);
            const f32x4 w0 = *(const f32x4*)(a.in[25] + c8), w1 = *(const f32x4*)(a.in[25] + c8 + 4);
            f32x4 o0 = (f32x4){bflo(r[k].x), bfhi(r[k].x), bflo(r[k].y), bfhi(r[k].y)}, o1 = (f32x4){bflo(r[k].z), bfhi(r[k].z), bflo(r[k].w), bfhi(r[k].w)};
            o0 = o0 * rstd * w0; o1 = o1 * rstd * w1;
            __builtin_nontemporal_store(o0, (f32x4*)(a.out + (size_t)row * 1024 + c8)); __builtin_nontemporal_store(o1, (f32x4*)(a.out + (size_t)row * 1024 + c8 + 4)); } }
    }
}

constexpr int NPHASE = 13;
__global__ void __launch_bounds__(512, 2) mega(Args a) {
    extern __shared__ __attribute__((aligned(16))) unsigned char shm[];
    LAS unsigned char* lds = (LAS unsigned char*)shm;
    cg::grid_group grid = cg::this_grid();
    volatile LAS unsigned* xst = (volatile LAS unsigned*)(lds + LDS_BYTES - 16);
    if (threadIdx.x == 0) { xst[0] = 0u; xst[1] = 0u; }
    __syncthreads();
    const XcdBarrier xbar = xcd_barrier_post((unsigned*)(a.ws + WS_BAR), xst);
    unsigned char* ws = a.ws;
    float* ss = (float*)(ws + WS_SS);
    bf16_t* xb = (bf16_t*)(ws + WS_XB); bf16_t* cat = (bf16_t*)(ws + WS_CAT); bf16_t* r1 = (bf16_t*)(ws + WS_R1);
#define PHASE_BEGIN(n) if (a.ph_lo <= (n) && (n) < a.ph_hi) {
#define PHASE_END(n) if ((n) + 1 < a.ph_hi) { xcd_barrier(xbar); } }
#ifndef REP_MASK
#define REP_MASK 0
#endif
#define REP_EN(n) (((REP_MASK) >> (n)) & 1)
    if (a.ph_hi > 1000) grid.sync();
    PHASE_BEGIN(0) phase_prologue(a, lds); if (REP_EN(0)) { xcd_barrier(xbar); phase_prologue(a, lds); } PHASE_END(0)
    PHASE_BEGIN(1) { EpiInEven E; E.O = r1; E.ss = ss; E.ssrc = ss; run_gemm(lds, xb, 1024, (const bf16_t*)(ws + WS_W_IN0), 3072, 1024, E); if (REP_EN(1)) { xcd_barrier(xbar); run_gemm(lds, xb, 1024, (const bf16_t*)(ws + WS_W_IN0), 3072, 1024, E); } } PHASE_END(1)
    PHASE_BEGIN(2) { const int G = gridDim.x, bx = blockIdx.x;
                  for (int it = bx; it < 256; it += G) hgrn_local_items(a, lds, it);
                  if (bx < (G & ~3)) sgu_items(a, lds, bx, G & ~3);
                  xcd_barrier(xbar);
                  for (int it = bx; it < 256; it += G) hgrn_seq_item(a, lds, it);
                  if (REP_EN(2)) { xcd_barrier(xbar); for (int it = bx; it < 256; it += G) hgrn_local_items(a, lds, it); }
                  if (REP_EN(14)) { xcd_barrier(xbar); for (int it = bx; it < 256; it += G) if ((it & 3) != 3) hgrn_seg_state(a, lds, it); if (bx < (G & ~3)) sgu_items(a, lds, bx, G & ~3); }
                  if (REP_EN(13)) { xcd_barrier(xbar); for (int it = bx; it < 256; it += G) hgrn_seq_item(a, lds, it); } } PHASE_END(2)
    PHASE_BEGIN(3) { EpiResid E; E.xb = xb; E.ss = ss + MTOK; run_gemm(lds, cat, 1024, (const bf16_t*)(ws + WS_W_OUT0), 1024, 1024, E); } PHASE_END(3)
    PHASE_BEGIN(4) { EpiSwiglu E; E.O = r1; E.ss = ss + MTOK; E.ssrc = ss + MTOK; run_gemm(lds, xb, 1024, (const bf16_t*)(ws + WS_W_GU0), 5632, 1024, E); if (REP_EN(4)) { xcd_barrier(xbar); run_gemm(lds, xb, 1024, (const bf16_t*)(ws + WS_W_GU0), 5632, 1024, E); } } PHASE_END(4)
    if (REP_MASK & 0xe0000) { if (a.ph_lo <= 4 && 4 < a.ph_hi) { EpiNull E; E.sink = (float*)(ws + WS_BAR + 8192);
        if (REP_EN(17)) run_gemm(lds, xb, 1024, (const bf16_t*)(ws + WS_W_IN0), 3072, 1024, E);
        if (REP_EN(18)) run_gemm(lds, r1, FF, (const bf16_t*)(ws + WS_W_D0), 1024, FF, E);
        if (REP_EN(19)) run_gemm(lds, cat, 1024, (const bf16_t*)(ws + WS_W_OUT0), 1024, 1024, E);
        xcd_barrier(xbar); } }
    PHASE_BEGIN(5) { EpiResid E; E.xb = xb; E.ss = ss + 2 * MTOK; run_gemm(lds, r1, FF, (const bf16_t*)(ws + WS_W_D0), 1024, FF, E); } PHASE_END(5)
    PHASE_BEGIN(6) { EpiInOdd E; E.hglu = (bf16_t*)(ws + WS_R1 + R1_HGLU); E.pqkv = (bf16_t*)(ws + WS_R1 + R1_PQKV); E.ss = ss + 2 * MTOK; E.ssrc = ss + 2 * MTOK; E.ssq = ss + 5 * MTOK; E.sskv = ss + 6 * MTOK;
                  E.thr = 3; E.off0 = 0; E.off1 = 1;
                  run_gemm(lds, xb, 1024, (const bf16_t*)(ws + WS_W_IN1), 1536, 1024, E); } PHASE_END(6)
    PHASE_BEGIN(7) { const int G = gridDim.x, bx = blockIdx.x;
                  { EpiInOdd E; E.hglu = (bf16_t*)(ws + WS_R1 + R1_HGLU); E.pqkv = (bf16_t*)(ws + WS_R1 + R1_PQKV); E.ss = ss + 2 * MTOK; E.ssrc = ss + 2 * MTOK; E.ssq = ss + 5 * MTOK; E.sskv = ss + 6 * MTOK;
                    E.thr = 1; E.off0 = 3; E.off1 = 3;
                    run_gemm(lds, xb, 1024, (const bf16_t*)(ws + WS_W_IN1) + (size_t)1536 * 1024, 256, 1024, E); }
                  { EpiUq E; E.Q = (bf16_t*)(ws + WS_R1 + R1_Q); E.ssq = ss + 5 * MTOK; E.ssrc = ss + 5 * MTOK;
                    if (G == 256) { ListOrder S; S.nM = 128; S.nN = 3; if (bx < 128) { S.first = bx; S.cnt = 1; } else { S.first = 128 + (bx - 128) * 2; S.cnt = 2; }
                        run_gemm_s(lds, (const bf16_t*)(ws + WS_R1 + R1_PQKV), 768, (const bf16_t*)(ws + WS_W_UQ), 768, 384, E, S); }
                    else run_gemm(lds, (const bf16_t*)(ws + WS_R1 + R1_PQKV), 768, (const bf16_t*)(ws + WS_W_UQ), 768, 384, E); }
                  { EpiUkv E; E.Kb = (bf16_t*)(ws + WS_R1 + R1_KB); E.Vt = (bf16_t*)(ws + WS_R1 + R1_VT); E.sskv = ss + 6 * MTOK; E.ssrc = ss + 6 * MTOK;
                    if (G == 256) { ListOrder S; S.nM = 128; S.nN = 4; if (bx < 128) { S.first = bx; S.cnt = 1; } else { S.first = 128 + (bx - 128) * 3; S.cnt = 3; }
                        run_gemm_s(lds, (const bf16_t*)(ws + WS_R1 + R1_PQKV) + 384, 768, (const bf16_t*)(ws + WS_W_UKV), 1024, 256, E, S); }
                    else run_gemm(lds, (const bf16_t*)(ws + WS_R1 + R1_PQKV) + 384, 768, (const bf16_t*)(ws + WS_W_UKV), 1024, 256, E); }
                  krope_items(a); } PHASE_END(7)
    PHASE_BEGIN(8) attn_items(a, lds); conv_items(a, lds); PHASE_END(8)
    PHASE_BEGIN(9) { EpiResid E; E.xb = xb; E.ss = ss + 3 * MTOK; run_gemm(lds, cat, 1024, (const bf16_t*)(ws + WS_W_OUT1), 1024, 1024, E); } PHASE_END(9)
    PHASE_BEGIN(10) { EpiSwiglu E; E.O = r1; E.ss = ss + 3 * MTOK; E.ssrc = ss + 3 * MTOK; run_gemm(lds, xb, 1024, (const bf16_t*)(ws + WS_W_GU1), 5632, 1024, E); } PHASE_END(10)
    PHASE_BEGIN(11) { EpiResid E; E.xb = xb; E.ss = ss + 4 * MTOK; run_gemm(lds, r1, FF, (const bf16_t*)(ws + WS_W_D1), 1024, FF, E); } PHASE_END(11)
    PHASE_BEGIN(12) final_norm(a); PHASE_END(12)
}

#ifndef MK_ONE_LAUNCH
#define MK_ONE_LAUNCH 1
#endif
extern "C" void kernel_launch(void* const* d_in, const int* in_sizes, int n_in, void* d_out, int out_size, void* d_ws, size_t ws_size, hipStream_t stream) {
    static int grid = 0;
    if (grid == 0) {
        if (n_in != 26 || out_size != MTOK * DM || ws_size < WS_END) { fprintf(stderr, "kernel_launch: unexpected shapes (n_in %d, out %d, ws %zu < %zu)\n", n_in, out_size, ws_size, (size_t)WS_END); grid = -1; return; }
        int dev = 0, cus = 0, per_cu = 0;
        hipGetDevice(&dev); hipDeviceGetAttribute(&cus, hipDeviceAttributeMultiprocessorCount, dev);
        if (hipFuncSetAttribute((const void*)mega, hipFuncAttributeMaxDynamicSharedMemorySize, LDS_BYTES) != hipSuccess) { fprintf(stderr, "kernel_launch: hipFuncSetAttribute failed\n"); grid = -1; return; }
        if (hipOccupancyMaxActiveBlocksPerMultiprocessor(&per_cu, (const void*)mega, 512, LDS_BYTES) != hipSuccess || per_cu < 1) { fprintf(stderr, "kernel_launch: occupancy query says %d\n", per_cu); per_cu = 1; }
        (void)hipGetLastError();
        grid = cus * 1;
    }
    if (grid < 0) return;
    if (hipMemsetAsync((char*)d_ws + WS_BAR, 0, XCD_BAR_WORDS * 4, stream) != hipSuccess) { fprintf(stderr, "kernel_launch: memset failed\n"); return; }
    Args a{};
    for (int i = 0; i < 26; ++i) a.in[i] = (const float*)d_in[i];
    a.out = (float*)d_out; a.ws = (unsigned char*)d_ws;
#if MK_ONE_LAUNCH
    a.ph_lo = 0; a.ph_hi = NPHASE;
    void* args[] = {&a};
    hipError_t e = hipLaunchCooperativeKernel((const void*)mega, dim3(grid), dim3(512), args, LDS_BYTES, stream);
    if (e != hipSuccess) fprintf(stderr, "cooperative launch failed: %s (grid %d)\n", hipGetErrorString(e), grid);
#else
    for (int ph = 0; ph < NPHASE; ++ph) { a.ph_lo = ph; a.ph_hi = ph + 1; hipLaunchKernelGGL(mega, dim3(grid), dim3(512), LDS_BYTES, stream, a); }
#endif
}
```
